# Optimizing an MI355X kernel written in HIP

```python
import math
import jax, jax.numpy as jnp
from jax import lax
import numpy as np

D_MODEL = 1024
BATCH = 4
SEQ = 4096
DEPTH = 1

SSD_EXPAND = 2
D_INNER = SSD_EXPAND * D_MODEL
SSD_HEAD_DIM = 64
SSD_HEADS = D_INNER // SSD_HEAD_DIM
SSD_GROUPS = 8
D_STATE = 128
CONV_K = 4
CONV_DIM = D_INNER + 2 * SSD_GROUPS * D_STATE
SSD_CHUNK = 128
SB_HEADS = 16
SB_HEAD_DIM = 64
SB_WIDTH = SB_HEADS * SB_HEAD_DIM
SB_BLOCK = 128
D_FF = 4 * D_MODEL
PLE_DIM = 256
N_BRANCHES = 2
RMS_EPS = 1e-6
IN_PROJ_DIM = D_INNER + CONV_DIM + SSD_HEADS + 3 * SB_WIDTH
SPLITS = [D_INNER, D_INNER + CONV_DIM, D_INNER + CONV_DIM + SSD_HEADS,
          D_INNER + CONV_DIM + SSD_HEADS + SB_WIDTH,
          D_INNER + CONV_DIM + SSD_HEADS + 2 * SB_WIDTH]

kernel_name = "hybrid_ssd_stickbreak_gated_block"


def rms_norm(x, w):
    xf = x.astype(jnp.float32)
    y = xf * lax.rsqrt(jnp.mean(xf * xf, axis=-1, keepdims=True) + RMS_EPS)
    return (y * w.astype(jnp.float32)).astype(x.dtype)


def causal_depthwise_conv(u, w, b):
    k = w.shape[0]
    c = u.shape[-1]
    y = lax.conv_general_dilated(u, w[:, None, :].astype(u.dtype), window_strides=(1,),
                                 padding=[(k - 1, 0)],
                                 dimension_numbers=("NWC", "WIO", "NWC"),
                                 feature_group_count=c)
    return y + b.astype(u.dtype)


def ssd_chunked_scan(xs, dt, a, bmat, cmat):
    bsz, seqlen, nh, hd = xs.shape
    ng, ns = bmat.shape[2], bmat.shape[3]
    r = nh // ng
    nc = seqlen // SSD_CHUNK
    shp = (bsz, nc, SSD_CHUNK, ng, r)
    xd = (xs * dt[..., None]).reshape(shp + (hd,))
    a_cs = jnp.cumsum((dt * a).reshape(shp), axis=2)
    bc = bmat.reshape(bsz, nc, SSD_CHUNK, ng, ns)
    cc = cmat.reshape(bsz, nc, SSD_CHUNK, ng, ns)
    seg = a_cs[:, :, :, None] - a_cs[:, :, None, :]
    causal = jnp.tril(jnp.ones((SSD_CHUNK, SSD_CHUNK), dtype=bool))[None, None, :, :, None, None]
    decay = jnp.exp(jnp.where(causal, seg, -jnp.inf))
    cb = jnp.einsum("bclgn,bcsgn->bclsg", cc, bc)
    y_diag = jnp.einsum("bclsgr,bcsgrp->bclgrp", cb[..., None] * decay, xd)
    decay_to_end = jnp.exp(a_cs[:, :, -1:] - a_cs)
    states = jnp.einsum("bcsgn,bcsgrp->bcgrpn", bc, xd * decay_to_end[..., None])
    chunk_decay = jnp.exp(a_cs[:, :, -1])

    def step(carry, inp):
        st, dec = inp
        return carry * dec[..., None, None] + st, carry

    init = jnp.zeros((bsz, ng, r, hd, ns), jnp.float32)
    _, prev = lax.scan(step, init, (jnp.moveaxis(states, 1, 0), jnp.moveaxis(chunk_decay, 1, 0)))
    prev = jnp.moveaxis(prev, 0, 1)
    y_off = jnp.einsum("bclgn,bcgrpn->bclgrp", cc, prev) * jnp.exp(a_cs)[..., None]
    return (y_diag + y_off).reshape(bsz, seqlen, nh, hd)


def ssd_mixer(z, xbc, dt_raw, conv_w, conv_b, dt_bias, a_log, d_skip, norm_w):
    bsz, seqlen, _ = z.shape
    xbc = jax.nn.silu(causal_depthwise_conv(xbc, conv_w, conv_b))
    xs, bmat, cmat = jnp.split(xbc, [D_INNER, D_INNER + SSD_GROUPS * D_STATE], axis=-1)
    xs = xs.astype(jnp.float32).reshape(bsz, seqlen, SSD_HEADS, SSD_HEAD_DIM)
    bmat = bmat.astype(jnp.float32).reshape(bsz, seqlen, SSD_GROUPS, D_STATE)
    cmat = cmat.astype(jnp.float32).reshape(bsz, seqlen, SSD_GROUPS, D_STATE)
    dt = jax.nn.softplus(dt_raw.astype(jnp.float32) + dt_bias.astype(jnp.float32))
    a = -jnp.exp(a_log.astype(jnp.float32))
    y = ssd_chunked_scan(xs, dt, a, bmat, cmat) + xs * d_skip.astype(jnp.float32)[:, None]
    y = y.reshape(bsz, seqlen, D_INNER) * jax.nn.silu(z.astype(jnp.float32))
    yg = y.reshape(bsz, seqlen, SSD_GROUPS, D_INNER // SSD_GROUPS)
    yg = yg * lax.rsqrt(jnp.mean(yg * yg, axis=-1, keepdims=True) + RMS_EPS)
    y = yg.reshape(bsz, seqlen, D_INNER) * norm_w.astype(jnp.float32)
    return y.astype(z.dtype)


def stick_breaking_attention(q, k, v):
    seqlen, hd = q.shape[2], q.shape[3]
    scale = hd ** -0.5
    outs = []
    for blk in range(seqlen // SB_BLOCK):
        t0 = blk * SB_BLOCK
        t1 = t0 + SB_BLOCK
        logits = jnp.einsum("bhtd,bhsd->bhts", q[:, :, t0:t1], k[:, :, :t1]).astype(jnp.float32) * scale
        mask = jnp.arange(t1)[None, :] < jnp.arange(t0, t1)[:, None]
        log_keep = jnp.where(mask, jax.nn.log_sigmoid(-logits), 0.0)
        later = jnp.flip(jnp.cumsum(jnp.flip(log_keep, -1), axis=-1), -1) - log_keep
        weights = jnp.where(mask, jnp.exp(jax.nn.log_sigmoid(logits) + later), 0.0)
        outs.append(jnp.einsum("bhts,bhsd->bhtd", weights, v[:, :, :t1].astype(jnp.float32)))
    return jnp.concatenate(outs, axis=2)


def setup_inputs(seed: int = 0) -> dict:
    key = jax.random.key(seed)
    ks = jax.random.split(key, 26)
    f32 = jnp.float32

    def nrm(k, shape, fan_in):
        return jax.random.normal(k, shape, f32) * (fan_in ** -0.5)

    def gain(k, shape):
        return 1.0 + 0.05 * jax.random.normal(k, shape, f32)

    dt0 = jnp.exp(jax.random.uniform(ks[6], (DEPTH, SSD_HEADS), f32)
                  * (math.log(0.1) - math.log(0.001)) + math.log(0.001))
    dt_bias = dt0 + jnp.log(-jnp.expm1(-dt0))
    a_log = jnp.log(jax.random.uniform(ks[7], (DEPTH, SSD_HEADS), f32, 1.0, 16.0))
    return {
        "x": jax.random.normal(ks[0], (BATCH, SEQ, D_MODEL), f32),
        "p": jax.random.normal(ks[1], (DEPTH, BATCH, SEQ, PLE_DIM), f32),
        "norm_mix_pre": gain(ks[2], (DEPTH, D_MODEL)),
        "w_in": nrm(ks[3], (DEPTH, D_MODEL, IN_PROJ_DIM), D_MODEL),
        "conv_w": nrm(ks[4], (DEPTH, CONV_K, CONV_DIM), CONV_K),
        "conv_b": 0.01 * jax.random.normal(ks[5], (DEPTH, CONV_DIM), f32),
        "dt_bias": dt_bias,
        "a_log": a_log,
        "d_skip": 1.0 + 0.1 * jax.random.normal(ks[8], (DEPTH, SSD_HEADS), f32),
        "ssd_norm": gain(ks[9], (DEPTH, D_INNER)),
        "w_ssd_branch": nrm(ks[10], (DEPTH, D_INNER, D_MODEL), D_INNER),
        "w_sb_branch": nrm(ks[11], (DEPTH, SB_WIDTH, D_MODEL), SB_WIDTH),
        "w_gate": nrm(ks[12], (DEPTH, D_MODEL, N_BRANCHES * D_MODEL), D_MODEL),
        "b_gate": 0.01 * jax.random.normal(ks[13], (DEPTH, N_BRANCHES * D_MODEL), f32),
        "w_out": nrm(ks[14], (DEPTH, D_MODEL, D_MODEL), D_MODEL),
        "norm_mix_post": gain(ks[15], (DEPTH, D_MODEL)),
        "norm_ffn_pre": gain(ks[16], (DEPTH, D_MODEL)),
        "w_ff1": nrm(ks[17], (DEPTH, D_MODEL, D_FF), D_MODEL),
        "w_ff2": nrm(ks[18], (DEPTH, D_FF, D_MODEL), D_FF),
        "norm_ffn_post": gain(ks[19], (DEPTH, D_MODEL)),
        "w_ple": nrm(ks[20], (DEPTH, PLE_DIM, D_MODEL), PLE_DIM),
        "w_ple_gate": nrm(ks[21], (DEPTH, D_MODEL, D_MODEL), D_MODEL),
        "norm_ple_post": gain(ks[22], (DEPTH, D_MODEL)),
    }


def reference(x, p, norm_mix_pre, w_in, conv_w, conv_b, dt_bias, a_log, d_skip, ssd_norm,
              w_ssd_branch, w_sb_branch, w_gate, b_gate, w_out, norm_mix_post,
              norm_ffn_pre, w_ff1, w_ff2, norm_ffn_post, w_ple, w_ple_gate, norm_ple_post):
    h = x
    bsz, seqlen, _ = x.shape
    for i in range(DEPTH):
        n1 = rms_norm(h, norm_mix_pre[i])
        proj = n1 @ w_in[i]
        z, xbc, dt_raw, q, k, v = jnp.split(proj, SPLITS, axis=-1)
        y_ssd = ssd_mixer(z, xbc, dt_raw, conv_w[i], conv_b[i], dt_bias[i], a_log[i],
                          d_skip[i], ssd_norm[i])
        heads = lambda t: t.reshape(bsz, seqlen, SB_HEADS, SB_HEAD_DIM).transpose(0, 2, 1, 3)
        y_sb = stick_breaking_attention(heads(q), heads(k), heads(v))
        y_sb = y_sb.transpose(0, 2, 1, 3).reshape(bsz, seqlen, SB_WIDTH).astype(h.dtype)
        gates = jax.nn.sigmoid((n1 @ w_gate[i] + b_gate[i]).astype(jnp.float32)).astype(h.dtype)
        g_ssd, g_sb = jnp.split(gates, N_BRANCHES, axis=-1)
        merged = g_ssd * (y_ssd @ w_ssd_branch[i]) + g_sb * (y_sb @ w_sb_branch[i])
        h = h + rms_norm(merged @ w_out[i], norm_mix_post[i])
        n2 = rms_norm(h, norm_ffn_pre[i])
        ff = jnp.square(jax.nn.relu(n2 @ w_ff1[i])) @ w_ff2[i]
        h = h + rms_norm(ff, norm_ffn_post[i])
        ple_gate = jax.nn.sigmoid((h @ w_ple_gate[i]).astype(jnp.float32)).astype(h.dtype)
        h = h + rms_norm(ple_gate * (p[i].astype(h.dtype) @ w_ple[i]), norm_ple_post[i])
    return h
```

```cpp
#include <hip/hip_runtime.h>
#include <hip/hip_cooperative_groups.h>
#include <cstdio>
#include <cstdint>
#include <cmath>
namespace cg = cooperative_groups;
#define GAS __attribute__((address_space(1)))
#define LAS __attribute__((address_space(3)))
typedef unsigned short bf16;
typedef unsigned v4u __attribute__((ext_vector_type(4)));
typedef float f32x4 __attribute__((ext_vector_type(4)));
typedef short bf16x8 __attribute__((ext_vector_type(8)));
namespace pg8 {
#define PG8_LAS __attribute__((address_space(3)))
typedef unsigned short bf16_t;
typedef short bf16x8 __attribute__((ext_vector_type(8)));
typedef float f32x4 __attribute__((ext_vector_type(4)));
typedef unsigned u32x4 __attribute__((ext_vector_type(4)));
constexpr int BM = 256, BK = 64, HALF = 128, HTB = HALF * BK * 2  , STAGE_BYTES = 8 * HTB, NXCD = 8, WGM = 8;

__host__ __device__ __forceinline__ int lds_byte(int r, int c) { const int st = (r >> 4) * 2 + (c >> 5), rr = r & 15, cc = c & 31, ob = rr * 64 + cc * 2; return st * 1024 + (ob ^ (((ob >> 9) & 1) << 5)); }
__host__ __device__ __forceinline__ void stage_rc(int b, int& R, int& C) { const int st = b / 1024, sb = b % 1024, swz = sb ^ (((sb >> 9) & 1) << 5); R = (st >> 1) * 16 + swz / 64; C = (st & 1) * 32 + (swz % 64) / 2; }
__host__ __device__ __forceinline__ int perm32(int rho) { const int n = rho >> 4, i = rho & 15; return 8 * (i >> 2) + 4 * n + (i & 3); }

struct Unit { int pm, pn; };
struct Gemm { const bf16_t* A; const bf16_t* Bt; int M, N, K; };

struct StaticOrder {
    int nM, nN, nwg, G, c;
    __host__ __device__ void init(int M, int N, int G_, int c_) { nM = M / BM; nN = N / BM; nwg = nM * nN; G = G_; c = c_; }
    __host__ __device__ bool next(int i, Unit& u) const {
        const long L = (long)i * G + c; if (L >= nwg) return false;
        int wgid = (int)L; { const int q = nwg / NXCD, r = nwg % NXCD, xcd = wgid % NXCD, off = wgid / NXCD; wgid = (xcd < r ? xcd * (q + 1) : r * (q + 1) + (xcd - r) * q) + off; }
        const int nig = WGM * nN, gid = wgid / nig, fm = gid * WGM, gsz = (nM - fm) < WGM ? (nM - fm) : WGM;
        u.pm = fm + ((wgid % nig) % gsz); u.pn = (wgid % nig) / gsz; return true;
    }
    __device__ __forceinline__ void a_ready(const Unit&) const {}
    __device__ __forceinline__ void done(const Unit&) const {}
};

template <class Epi, class Sched, bool ALIGN_EPI = false, bool SP2 = false>
__device__ __forceinline__ void gemm_phase(PG8_LAS unsigned char* lds, const Gemm g, const Sched& S, const Epi& E) {
    const int tid = threadIdx.x, wid = __builtin_amdgcn_readfirstlane(tid >> 6), lane = tid & 63, wr = wid >> 2, wc = wid & 3, fr = lane & 15, fq = lane >> 4;
    const int K = g.K, nt = K / BK;
    unsigned voffA[2], voffB[2];
#pragma unroll
    for (int i = 0; i < 2; ++i) { int R, C; stage_rc(tid * 16 + i * 8192, R, C); const int Rb = Epi::PERM ? ((R & ~31) + perm32(R & 31)) : R;
        voffA[i] = (unsigned)(R * K + C) * 2u; voffB[i] = (unsigned)(Rb * K + C) * 2u; }
    const size_t kstep = (size_t)(BK * 2);
    const size_t hstep = (size_t)HALF * K * 2;
    const size_t tstep = 2 * hstep;
    const unsigned ldsw = (unsigned)wid * 1024u;
    const int aoff = lds_byte(wr * 64 + fr, fq * 8), boff = lds_byte(wc * 32 + fr, fq * 8);
#define PG8_SA(b, h) (((b) * 2 + (h)) * HTB)
#define PG8_SB(b, h) ((4 + (b) * 2 + (h)) * HTB)
#define PG8_STAGE(bufoff, gbase, voff) do { _Pragma("unroll") for (int _i = 0; _i < 2; ++_i) \
        __builtin_amdgcn_global_load_lds((const unsigned*)((const char*)(gbase) + (voff)[_i]), (PG8_LAS unsigned*)(lds + (bufoff) + ldsw + _i * 8192), 16, 0, 0); } while (0)
#define PG8_LDA(dst, b, h) do { _Pragma("unroll") for (int m = 0; m < 4; ++m) _Pragma("unroll") for (int k = 0; k < 2; ++k) dst[m][k] = *(const PG8_LAS bf16x8*)(lds + PG8_SA(b, h) + aoff + m * 2048 + k * 1024); } while (0)
#define PG8_LDB(dst, b, h) do { _Pragma("unroll") for (int n = 0; n < 2; ++n) _Pragma("unroll") for (int k = 0; k < 2; ++k) dst[n][k] = *(const PG8_LAS bf16x8*)(lds + PG8_SB(b, h) + boff + n * 2048 + k * 1024); } while (0)
#define PG8_MMA(ai, bj, At, Bt) do { __builtin_amdgcn_s_setprio(1); _Pragma("unroll") for (int m = 0; m < 4; ++m) _Pragma("unroll") for (int n = 0; n < 2; ++n) _Pragma("unroll") for (int k = 0; k < 2; ++k) \
        acc[ai][bj][m][n] = __builtin_amdgcn_mfma_f32_16x16x32_bf16(Bt[n][k], At[m][k], acc[ai][bj][m][n], 0, 0, 0); __builtin_amdgcn_s_setprio(0); } while (0)
#define PG8_WAIT_V(n) asm volatile("s_waitcnt vmcnt(" #n ")" ::: "memory")
#define PG8_WAIT_L(n) asm volatile("s_waitcnt lgkmcnt(" #n ")" ::: "memory")
#define PG8_BAR __builtin_amdgcn_s_barrier()
#define PG8_SCHED __builtin_amdgcn_sched_barrier(0)
    Unit cur, nxt; int ui = 0;
    if (!S.next(0, cur)) return;
    f32x4 acc[2][2][4][2];
#pragma unroll
    for (int a = 0; a < 2; ++a)
#pragma unroll
        for (int b = 0; b < 2; ++b)
#pragma unroll
            for (int m = 0; m < 4; ++m)
#pragma unroll
                for (int n = 0; n < 2; ++n) acc[a][b][m][n] = (f32x4){0.f, 0.f, 0.f, 0.f};
    bf16x8 At[4][2], B0[2][2], B1[2][2];
    const char* cA = (const char*)g.A + (size_t)cur.pm * tstep; const char* cB = (const char*)g.Bt + (size_t)cur.pn * tstep;
    S.a_ready(cur);
    if constexpr (SP2) {
        PG8_STAGE(PG8_SB(0, 0), cB, voffB); PG8_STAGE(PG8_SB(0, 1), cB + hstep, voffB); PG8_STAGE(PG8_SA(0, 0), cA, voffA); PG8_STAGE(PG8_SA(0, 1), cA + hstep, voffA);
        if (wr == 1) PG8_BAR;
        PG8_WAIT_V(2); PG8_BAR;
        PG8_STAGE(PG8_SB(1, 0), cB + kstep, voffB); PG8_STAGE(PG8_SA(1, 0), cA + kstep, voffA); PG8_STAGE(PG8_SB(1, 1), cB + hstep + kstep, voffB);
        PG8_WAIT_V(6); PG8_BAR;
    } else {
        PG8_STAGE(PG8_SB(0, 0), cB, voffB); PG8_STAGE(PG8_SA(0, 0), cA, voffA); PG8_STAGE(PG8_SB(0, 1), cB + hstep, voffB); PG8_STAGE(PG8_SA(0, 1), cA + hstep, voffA);
        if (wr == 1) PG8_BAR;
        PG8_WAIT_V(4); PG8_BAR;
        PG8_STAGE(PG8_SB(1, 0), cB + kstep, voffB); PG8_STAGE(PG8_SA(1, 0), cA + kstep, voffA); PG8_STAGE(PG8_SB(1, 1), cB + hstep + kstep, voffB);
        PG8_WAIT_V(6); PG8_BAR;
    }
    for (;;) {
        const bool has_next = S.next(ui + 1, nxt);
        const char* nA = has_next ? (const char*)g.A + (size_t)nxt.pm * tstep : cA; const char* nB = has_next ? (const char*)g.Bt + (size_t)nxt.pn * tstep : cB;
        for (int t = 0; t < nt; t += 2) {
            const bool last = (t == nt - 2);
            const char* a1 = cA + (size_t)(t + 1) * kstep;
            const char* a2 = last ? nA : cA + (size_t)(t + 2) * kstep; const char* b2 = last ? nB : cB + (size_t)(t + 2) * kstep;
            const char* a3 = a2 + kstep; const char* b3 = b2 + kstep;
            if (last && has_next) S.a_ready(nxt);
            if constexpr (SP2) {
            PG8_LDB(B0, 0, 0); PG8_LDB(B1, 0, 1); PG8_SCHED; PG8_LDA(At, 0, 0); PG8_STAGE(PG8_SA(1, 1), a1 + hstep, voffA);
            PG8_WAIT_V(8); PG8_WAIT_L(0); PG8_BAR; PG8_MMA(0, 0, At, B0); PG8_MMA(0, 1, At, B1); PG8_BAR; PG8_SCHED;
            PG8_LDA(At, 0, 1); PG8_STAGE(PG8_SB(0, 0), b2, voffB); PG8_STAGE(PG8_SB(0, 1), b2 + hstep, voffB); PG8_STAGE(PG8_SA(0, 0), a2, voffA);
            PG8_WAIT_V(8); PG8_WAIT_L(0); PG8_BAR; PG8_MMA(1, 0, At, B0); PG8_MMA(1, 1, At, B1); PG8_BAR; PG8_SCHED;
            PG8_LDB(B0, 1, 0); PG8_LDB(B1, 1, 1); PG8_SCHED; PG8_LDA(At, 1, 0); PG8_STAGE(PG8_SA(0, 1), a2 + hstep, voffA);
            PG8_WAIT_V(8); PG8_WAIT_L(0); PG8_BAR; PG8_MMA(0, 0, At, B0); PG8_MMA(0, 1, At, B1); PG8_BAR; PG8_SCHED;
            PG8_LDA(At, 1, 1); PG8_STAGE(PG8_SB(1, 0), b3, voffB); PG8_STAGE(PG8_SB(1, 1), b3 + hstep, voffB); PG8_STAGE(PG8_SA(1, 0), a3, voffA);
            PG8_WAIT_V(8); PG8_WAIT_L(0); PG8_BAR; PG8_MMA(1, 0, At, B0); PG8_MMA(1, 1, At, B1); PG8_BAR; PG8_SCHED;
            } else {
            PG8_LDB(B0, 0, 0); PG8_SCHED; PG8_LDA(At, 0, 0); PG8_STAGE(PG8_SA(1, 1), a1 + hstep, voffA);
            PG8_WAIT_L(8); PG8_BAR; PG8_WAIT_L(0); PG8_MMA(0, 0, At, B0); PG8_BAR; PG8_SCHED;
            PG8_LDB(B1, 0, 1); PG8_STAGE(PG8_SB(0, 0), b2, voffB);
            PG8_BAR; PG8_WAIT_L(0); PG8_MMA(0, 1, At, B1); PG8_BAR;
            PG8_LDA(At, 0, 1); PG8_STAGE(PG8_SA(0, 0), a2, voffA);
            PG8_BAR; PG8_WAIT_L(0); PG8_MMA(1, 0, At, B0); PG8_BAR; PG8_SCHED;
            PG8_STAGE(PG8_SB(0, 1), b2 + hstep, voffB);
            PG8_WAIT_V(6); PG8_BAR; PG8_MMA(1, 1, At, B1); PG8_BAR;
            PG8_LDB(B0, 1, 0); PG8_SCHED; PG8_LDA(At, 1, 0); PG8_STAGE(PG8_SA(0, 1), a2 + hstep, voffA);
            PG8_WAIT_L(8); PG8_BAR; PG8_WAIT_L(0); PG8_MMA(0, 0, At, B0); PG8_BAR; PG8_SCHED;
            PG8_LDB(B1, 1, 1); PG8_STAGE(PG8_SB(1, 0), b3, voffB);
            PG8_BAR; PG8_WAIT_L(0); PG8_MMA(0, 1, At, B1); PG8_BAR;
            PG8_LDA(At, 1, 1); PG8_STAGE(PG8_SA(1, 0), a3, voffA);
            PG8_BAR; PG8_WAIT_L(0); PG8_MMA(1, 0, At, B0); PG8_BAR; PG8_SCHED;
            PG8_STAGE(PG8_SB(1, 1), b3 + hstep, voffB);
            PG8_WAIT_V(6); PG8_BAR; PG8_MMA(1, 1, At, B1); PG8_BAR;
            }
        }
        if constexpr (ALIGN_EPI) { if (wr == 0) PG8_BAR; }
        if constexpr (!Epi::AFTER_DRAIN) { E(acc, cur, wr, wc, fr, fq); S.done(cur); }
        if (!has_next) break;
#pragma unroll
        for (int a = 0; a < 2; ++a)
#pragma unroll
            for (int b = 0; b < 2; ++b)
#pragma unroll
                for (int m = 0; m < 4; ++m)
#pragma unroll
                    for (int n = 0; n < 2; ++n) acc[a][b][m][n] = (f32x4){0.f, 0.f, 0.f, 0.f};
        cur = nxt; cA = nA; cB = nB; ++ui;
        if constexpr (ALIGN_EPI) { if (wr == 1) PG8_BAR; }
    }
    PG8_WAIT_V(0);
    if constexpr (!ALIGN_EPI) { if (wr == 0) PG8_BAR; }
    PG8_BAR;
    if constexpr (Epi::AFTER_DRAIN) { E.fused(acc, cur, wr, wc, fr, fq, lds, wid, lane); S.done(cur); }
#undef PG8_SA
#undef PG8_SB
#undef PG8_STAGE
#undef PG8_LDA
#undef PG8_LDB
#undef PG8_MMA
#undef PG8_WAIT_V
#undef PG8_WAIT_L
#undef PG8_BAR
#undef PG8_SCHED
}
}
#define XB_TMO      128
#define XB_XCNT(j)  (256  + 64 * (j))
#define XB_XSUB(j)  (1280 + 64 * (j))
#define XB_XGEN(j)  (2304 + 64 * (j))
#define XB_TOP      3328
#define XB_TOPGEN   3392
#define XCD_BAR_WORDS 3456
#define XB_SPIN_CAP (1u << 18)

__device__ __forceinline__ unsigned xb_ld(unsigned* p)              { return __hip_atomic_load(p, __ATOMIC_RELAXED, __HIP_MEMORY_SCOPE_AGENT); }
__device__ __forceinline__ unsigned xb_add(unsigned* p, unsigned v) { return __hip_atomic_fetch_add(p, v, __ATOMIC_RELAXED, __HIP_MEMORY_SCOPE_AGENT); }
__device__ __forceinline__ unsigned xb_xcc_id() { return (unsigned)__builtin_amdgcn_s_getreg((3 << 11) | 20) & 0xFu; }
#define XB_SPIN(cond, bar) do { unsigned _sp = 0; while (cond) { __builtin_amdgcn_s_sleep(1); \
    if ((++_sp & 255u) == 0u) { if (xb_ld(&(bar)[XB_TMO])) break; if (_sp > XB_SPIN_CAP) { atomicAdd(&(bar)[XB_TMO], 1u); break; } } } } while (0)

struct XcdBarrier {
    unsigned* bar; unsigned x;
    volatile LAS unsigned* st;
};

__device__ __forceinline__ XcdBarrier xcd_barrier_post(unsigned* bar, volatile LAS unsigned* st) {
    XcdBarrier b; b.bar = bar; b.x = xb_xcc_id(); b.st = st;
    if (threadIdx.x == 0) (void)xb_add(&bar[XB_XCNT(b.x)], 1u);
    return b;
}
__device__ __forceinline__ void xcd_barrier_complete(unsigned* bar, unsigned x, unsigned& nloc, unsigned& nx) {
    const unsigned G = gridDim.x * gridDim.y * gridDim.z;
    unsigned sum, cnt, mine, sp = 0u;
    for (;;) {
        sum = 0u; cnt = 0u; mine = 0u;
#pragma unroll
        for (unsigned j = 0; j < 16; ++j) { const unsigned c = xb_ld(&bar[XB_XCNT(j)]); sum += c; cnt += (c > 0u) ? 1u : 0u; mine = (j == x) ? c : mine; }
        if (sum == G) break;
        __builtin_amdgcn_s_sleep(1);
        if ((++sp & 255u) == 0u) { if (xb_ld(&bar[XB_TMO])) break; if (sp > XB_SPIN_CAP) { atomicAdd(&bar[XB_TMO], 1u); break; } }
    }
    nloc = mine > 0u ? mine : 1u; nx = cnt > 0u ? cnt : 1u;
}

__device__ __forceinline__ void xcd_barrier(const XcdBarrier& b) {
    asm volatile("s_waitcnt vmcnt(0)" ::: "memory");
    __syncthreads();
    if (threadIdx.x == 0) {
        unsigned* bar = b.bar;
        __builtin_amdgcn_s_waitcnt(0);
        unsigned nloc = b.st[0], nx = b.st[1];
        if (nloc == 0u) { xcd_barrier_complete(bar, b.x, nloc, nx); b.st[0] = nloc; b.st[1] = nx; }
        const unsigned old = xb_add(&bar[XB_XSUB(b.x)], 1u);
        const unsigned gen = old / nloc;
        if (old + 1u == (gen + 1u) * nloc) {
            __builtin_amdgcn_fence(__ATOMIC_RELEASE, "agent");
            asm volatile("s_waitcnt vmcnt(0)" ::: "memory");
            const unsigned og = xb_add(&bar[XB_TOP], 1u);
            const unsigned tg = og / nx;
            if (og + 1u == (tg + 1u) * nx) xb_add(&bar[XB_TOPGEN], 1u);
            else XB_SPIN(xb_ld(&bar[XB_TOPGEN]) == tg, bar);
            __builtin_amdgcn_fence(__ATOMIC_ACQUIRE, "agent");
            xb_add(&bar[XB_XGEN(b.x)], 1u);
            asm volatile("s_waitcnt vmcnt(0)" ::: "memory");
        } else {
            XB_SPIN(xb_ld(&bar[XB_XGEN(b.x)]) == gen, bar);
            __builtin_amdgcn_fence(__ATOMIC_ACQUIRE, "agent");
            asm volatile("s_waitcnt vmcnt(0)" ::: "memory");
        }
    }
    __syncthreads();
}

typedef float f32x16 __attribute__((ext_vector_type(16)));
typedef unsigned v2u __attribute__((ext_vector_type(2)));
typedef short s16x4 __attribute__((ext_vector_type(4)));
typedef __bf16 bf16x2_t __attribute__((ext_vector_type(2)));
typedef float f32x2_t __attribute__((ext_vector_type(2)));
#define DI __device__ __forceinline__
#define MFMA32(a, b, c) __builtin_amdgcn_mfma_f32_32x32x16_bf16((a), (b), (c), 0, 0, 0)
DI unsigned pk2(float lo, float hi) { f32x2_t v = {lo, hi}; bf16x2_t b = __builtin_convertvector(v, bf16x2_t); return __builtin_bit_cast(unsigned, b); }
DI float bflo(unsigned u) { return __uint_as_float(u << 16); }
DI float bfhi(unsigned u) { return __uint_as_float(u & 0xffff0000u); }
DI int crow(int r, int hi) { return (r & 3) + 8 * (r >> 2) + 4 * hi; }
DI float wave_sum(float v) {
#pragma unroll
    for (int o = 1; o < 64; o <<= 1) v += __shfl_xor(v, o);
    return v;
}
DI float sigm(float x) { return __builtin_amdgcn_rcpf(1.f + __expf(-x)); }

constexpr int M = 16384, DM = 1024, MH = 8192, SEQ = 4096, N1 = 9472, DFF = 4096;
constexpr float RMS_EPS = 1e-6f;
constexpr size_t MiB = 1u << 20;
constexpr size_t WS_CTL = 0, CTL_BYTES = 16384;
constexpr size_t WS_WG = 1 * MiB, WS_WSSD = 5 * MiB, WS_WSB = 9 * MiB, WS_WOUT = 11 * MiB, WS_WFF1 = 13 * MiB, WS_WFF2 = 21 * MiB, WS_WPG = 29 * MiB, WS_WPLE = 31 * MiB;
constexpr size_t WS_CD = 31 * MiB + 512 * 1024;
constexpr size_t WS_DT = 32 * MiB, WS_XN = 34 * MiB, WS_YS = 66 * MiB, WS_YSB = 130 * MiB, WS_XBC = 162 * MiB, WS_W1 = 226 * MiB;
constexpr size_t WS_T2 = 162 * MiB, WS_MG = 66 * MiB, WS_MO = 98 * MiB, WS_N2 = 34 * MiB, WS_HID = 128 * MiB, WS_FO = 34 * MiB, WS_H2B = 98 * MiB, WS_PB = 130 * MiB, WS_PL = 162 * MiB;
constexpr size_t DO_K = 0, DO_V = 16 * MiB, DO_ST = 32 * MiB;
constexpr int LDS_TOTAL = 147456, MISC_OFF = LDS_TOTAL - 128;

struct Args { const float* in[23]; float* out; unsigned char* ws; };

using pg8::Unit;
struct Epi1 {
    static constexpr bool PERM = true, AFTER_DRAIN = false;
    bf16 *Z, *XBC, *Q, *Kh, *Vh; float* DT; const float* dt_bias; int row_off;
    DI void operator()(const f32x4 (&acc)[2][2][4][2], const Unit& u, int wr, int wc, int fr, int fq) const {
        const int pn = u.pn; const int rl0 = u.pm * 256 + wr * 64 + fr;
        if (pn < 36) {
            bf16* base; int ldc, colt, radd;
            if (pn < 8) { base = Z; ldc = 2048; colt = pn * 256; radd = row_off; }
            else if (pn < 24) { base = XBC; ldc = 4096; colt = (pn - 8) * 256; radd = 0; }
            else if (pn < 28) { base = Q; ldc = 1024; colt = (pn - 24) * 256; radd = row_off; }
            else if (pn < 32) { base = Kh; ldc = 1024; colt = (pn - 28) * 256; radd = 0; }
            else { base = Vh; ldc = 1024; colt = (pn - 32) * 256; radd = 0; }
            const int col0 = colt + wc * 32 + 8 * fq;
#pragma unroll
            for (int ai = 0; ai < 2; ++ai)
#pragma unroll
                for (int m = 0; m < 4; ++m) { bf16* rowp = base + (size_t)(radd + rl0 + ai * 128 + m * 16) * ldc + col0;
#pragma unroll
                    for (int bj = 0; bj < 2; ++bj) { const f32x4 v0 = acc[ai][bj][m][0], v1 = acc[ai][bj][m][1];
                        v4u w; w.x = pk2(v0[0], v0[1]); w.y = pk2(v0[2], v0[3]); w.z = pk2(v1[0], v1[1]); w.w = pk2(v1[2], v1[3]);
                        *(v4u*)(rowp + bj * 128) = w; } }
        } else if (wc == 0) {
            const int c0 = 8 * fq;
#pragma unroll
            for (int ai = 0; ai < 2; ++ai)
#pragma unroll
                for (int m = 0; m < 4; ++m) { float* rowp = DT + (size_t)(row_off + rl0 + ai * 128 + m * 16) * 32 + c0;
#pragma unroll
                    for (int n = 0; n < 2; ++n) *(f32x4*)(rowp + 4 * n) = acc[ai][0][m][n]; }
        }
    }
};
template <int MODE> struct EpiF {
    static constexpr bool PERM = false, AFTER_DRAIN = false;
    float* O; const float* bias; const float* P; const float* Q2; bf16* OB;
    DI void operator()(const f32x4 (&acc)[2][2][4][2], const Unit& u, int wr, int wc, int fr, int fq) const {
        const int row0 = u.pm * 256 + wr * 64 + fr, col0 = u.pn * 256 + wc * 32 + 4 * fq;
#pragma unroll
        for (int ai = 0; ai < 2; ++ai)
#pragma unroll
            for (int m = 0; m < 4; ++m) { const size_t ro = (size_t)(row0 + ai * 128 + m * 16) * 1024;
#pragma unroll
                for (int bj = 0; bj < 2; ++bj)
#pragma unroll
                    for (int n = 0; n < 2; ++n) { const int c = col0 + bj * 128 + n * 16; const f32x4 v = acc[ai][bj][m][n];
                        if (MODE == 0) { *(f32x4*)(O + ro + c) = v; }
                        else { f32x4 g; const f32x4 bv = bias ? *(const f32x4*)(bias + c) : (f32x4){0.f, 0.f, 0.f, 0.f};
#pragma unroll
                            for (int j = 0; j < 4; ++j) g[j] = sigm(v[j] + bv[j]);
                            if (MODE == 1) { const f32x4 o = *(const f32x4*)(O + ro + c); *(f32x4*)(O + ro + c) = g * o; }
                            else { const f32x4 p = *(const f32x4*)(P + ro + c), q = *(const f32x4*)(Q2 + ro + c); const f32x4 r = p + g * q;
                                v2u w; w.x = pk2(r[0], r[1]); w.y = pk2(r[2], r[3]); *(v2u*)(OB + ro + c) = w; } } } }
    }
};
struct EpiRelu2 {
    static constexpr bool PERM = true, AFTER_DRAIN = false;
    bf16* O;
    DI void operator()(const f32x4 (&acc)[2][2][4][2], const Unit& u, int wr, int wc, int fr, int fq) const {
        const int row0 = u.pm * 256 + wr * 64 + fr, col0 = u.pn * 256 + wc * 32 + 8 * fq;
#pragma unroll
        for (int ai = 0; ai < 2; ++ai)
#pragma unroll
            for (int m = 0; m < 4; ++m) { bf16* rowp = O + (size_t)(row0 + ai * 128 + m * 16) * DFF + col0;
#pragma unroll
                for (int bj = 0; bj < 2; ++bj) { f32x4 v0 = acc[ai][bj][m][0], v1 = acc[ai][bj][m][1];
#pragma unroll
                    for (int j = 0; j < 4; ++j) { const float a = fmaxf(v0[j], 0.f), b = fmaxf(v1[j], 0.f); v0[j] = a * a; v1[j] = b * b; }
                    v4u w; w.x = pk2(v0[0], v0[1]); w.y = pk2(v0[2], v0[3]); w.z = pk2(v1[0], v1[1]); w.w = pk2(v1[2], v1[3]);
                    *(v4u*)(rowp + bj * 128) = w; } }
    }
};

struct Frame {
    LAS unsigned char* lds; int tid, lane, wave, G, bid;
    const __attribute__((address_space(4))) Args* A; float* out; unsigned char* ws;
};
#define LDS_WAIT() asm volatile("s_waitcnt lgkmcnt(0)" ::: "memory")

DI void tr_item(const float* W, int N, int K, bf16* WT, int k0, int n0, int drow, LAS float* scr, int lane) {
#pragma unroll 8
    for (int i = 0; i < 32; ++i) { const int kk = 2 * i + (lane >> 5); scr[kk * 33 + (lane & 31)] = W[(size_t)(k0 + kk) * N + n0 + (lane & 31)]; }
    LDS_WAIT();
    const int c = lane & 7;
#pragma unroll
    for (int j = 0; j < 4; ++j) { const int n = (lane >> 3) + 8 * j; const LAS float* s = scr + (8 * c) * 33 + n;
        v4u o; o.x = pk2(s[0 * 33], s[1 * 33]); o.y = pk2(s[2 * 33], s[3 * 33]); o.z = pk2(s[4 * 33], s[5 * 33]); o.w = pk2(s[6 * 33], s[7 * 33]);
        *(v4u*)(WT + (size_t)(drow + n) * K + k0 + 8 * c) = o; }
    LDS_WAIT();
}
DI void rms_row_bf16(const float* xrow, const float* w, bf16* orow, int lane) {
    f32x4 v[4]; float s = 0.f;
#pragma unroll
    for (int j = 0; j < 4; ++j) { v[j] = ((const f32x4*)xrow)[lane + 64 * j]; s += (v[j].x * v[j].x + v[j].y * v[j].y) + (v[j].z * v[j].z + v[j].w * v[j].w); }
    const float r = rsqrtf(wave_sum(s) * (1.f / 1024.f) + RMS_EPS);
#pragma unroll
    for (int j = 0; j < 4; ++j) { const f32x4 wv = ((const f32x4*)w)[lane + 64 * j]; v2u o; o.x = pk2(v[j].x * r * wv.x, v[j].y * r * wv.y); o.y = pk2(v[j].z * r * wv.z, v[j].w * r * wv.w);
        ((v2u*)orow)[lane + 64 * j] = o; }
}
DI void p0_prologue(Frame& F) {
    LAS float* scr = (LAS float*)(F.lds + F.wave * 16384);
    const int gw = F.bid * 8 + F.wave, NGW = F.G * 8;
    unsigned char* ws = F.ws;
    constexpr int I_IN = 16 * 289, I_G = 16 * 64, I_SSD = 32 * 32, I_SB = 16 * 32, I_OUT = 16 * 32, I_F1 = 16 * 128, I_F2 = 64 * 32, I_PLE = 4 * 32, I_PG = 16 * 32;
    constexpr int NITEMS = I_IN + I_G + I_SSD + I_SB + I_OUT + I_F1 + I_F2 + I_PLE + I_PG;
    for (int it = gw; it < NITEMS; it += NGW) {
        int r = it;
        if (r < I_IN) { const int kb = r / 289, nb = r % 289, n0 = 32 * nb; const int drow = n0 < 6144 ? n0 : (n0 < 6176 ? 9216 + (n0 - 6144) : n0 - 32);
            tr_item(F.A->in[3], 9248, 1024, (bf16*)(ws + WS_W1), 64 * kb, n0, drow, scr, F.lane); continue; } r -= I_IN;
#define TRM(CNT, IDX, NN, KK, OFF) if (r < CNT) { const int nblk = (NN) / 32, kb = r / nblk, nb = r % nblk; tr_item(F.A->in[IDX], NN, KK, (bf16*)(ws + OFF), 64 * kb, 32 * nb, 32 * nb, scr, F.lane); continue; } r -= CNT;
        TRM(I_G, 12, 2048, 1024, WS_WG)
        TRM(I_SSD, 10, 1024, 2048, WS_WSSD)
        TRM(I_SB, 11, 1024, 1024, WS_WSB)
        TRM(I_OUT, 14, 1024, 1024, WS_WOUT)
        TRM(I_F1, 17, 4096, 1024, WS_WFF1)
        TRM(I_F2, 18, 1024, 4096, WS_WFF2)
        TRM(I_PLE, 20, 1024, 256, WS_WPLE)
        TRM(I_PG, 21, 1024, 1024, WS_WPG)
#undef TRM
    }
    { v4u* z = (v4u*)((bf16*)(ws + WS_W1) + (size_t)9248 * 1024); const int n16 = 224 * 1024 * 2 / 16;
      for (int i = F.bid * 512 + F.tid; i < n16; i += F.G * 512) z[i] = (v4u){0u, 0u, 0u, 0u}; }
    for (int m = gw; m < M; m += NGW) rms_row_bf16(F.A->in[0] + (size_t)m * DM, F.A->in[2], (bf16*)(ws + WS_XN) + (size_t)m * DM, F.lane);
}

DI void attn_wave_unit(bf16* QO, const bf16* Kh, const bf16* Vh, int hb, int bl, int h, int qb, LAS unsigned short* vts, int lane) {
    const int r32 = lane & 31, hi = lane >> 5;
    const size_t rowQ = (size_t)(hb * 2 + bl) * SEQ, rowK = (size_t)bl * SEQ;
    bf16x8 qf[4];
    { const bf16* qp = QO + (rowQ + qb * 32 + r32) * 1024 + h * 64 + 8 * hi;
#pragma unroll
      for (int d0 = 0; d0 < 4; ++d0) qf[d0] = *(const bf16x8*)(qp + 16 * d0); }
    f32x16 o0, o1;
#pragma unroll
    for (int i = 0; i < 16; ++i) { o0[i] = 0.f; o1[i] = 0.f; }
    float R = 0.f;
    const int qabs = qb * 32 + r32;
    const float C2 = 0.125f * 1.4426950408889634f;
    for (int kt = qb; kt >= 0; --kt) {
        bf16x8 kf[4];
        { const bf16* kp = Kh + (rowK + kt * 32 + r32) * 1024 + h * 64 + 8 * hi;
#pragma unroll
          for (int d0 = 0; d0 < 4; ++d0) kf[d0] = *(const bf16x8*)(kp + 16 * d0); }
        { const int key = lane & 31, dq = lane >> 5; const bf16* vp = Vh + (rowK + kt * 32 + key) * 1024 + h * 64 + 32 * dq;
#pragma unroll
          for (int c = 0; c < 4; ++c) { const bf16x8 v = *(const bf16x8*)(vp + 8 * c);
#pragma unroll
              for (int j = 0; j < 8; ++j) vts[(32 * dq + 8 * c + j) * 36 + key] = (unsigned short)v[j]; } }
        f32x16 s;
#pragma unroll
        for (int i = 0; i < 16; ++i) s[i] = 0.f;
#pragma unroll
        for (int d0 = 0; d0 < 4; ++d0) s = MFMA32(kf[d0], qf[d0], s);
        float lk[16], ls[16];
#pragma unroll
        for (int i = 0; i < 16; ++i) {
            const float z2 = s[i] * C2; const float e = __builtin_amdgcn_exp2f(-fabsf(z2)); const float sp = fmaxf(z2, 0.f) + __log2f(1.f + e);
            lk[i] = -sp; ls[i] = z2 - sp;
        }
        if (kt == qb) {
#pragma unroll
            for (int i = 0; i < 16; ++i) { const bool valid = (kt * 32 + crow(i, hi)) < qabs; lk[i] = valid ? lk[i] : 0.f; ls[i] = valid ? ls[i] : -INFINITY; }
        }
        float gs[4], og[4], T[4];
#pragma unroll
        for (int a = 0; a < 4; ++a) { gs[a] = (lk[4 * a] + lk[4 * a + 1]) + (lk[4 * a + 2] + lk[4 * a + 3]); og[a] = __shfl_xor(gs[a], 32); T[a] = gs[a] + og[a]; }
        float ST[4]; ST[3] = 0.f; ST[2] = T[3]; ST[1] = T[3] + T[2]; ST[0] = ST[1] + T[1];
        float p[16];
#pragma unroll
        for (int a = 0; a < 4; ++a) {
            const float l3 = R + ST[a] + (hi == 0 ? og[a] : 0.f);
            const float l2 = l3 + lk[4 * a + 3], l1 = l2 + lk[4 * a + 2], l0 = l1 + lk[4 * a + 1];
            p[4 * a + 3] = __builtin_amdgcn_exp2f(ls[4 * a + 3] + l3); p[4 * a + 2] = __builtin_amdgcn_exp2f(ls[4 * a + 2] + l2);
            p[4 * a + 1] = __builtin_amdgcn_exp2f(ls[4 * a + 1] + l1); p[4 * a] = __builtin_amdgcn_exp2f(ls[4 * a] + l0);
        }
        R += (T[0] + T[1]) + (T[2] + T[3]);
        LDS_WAIT();
#pragma unroll
        for (int ks = 0; ks < 2; ++ks) {
            v4u pw; pw.x = pk2(p[8 * ks], p[8 * ks + 1]); pw.y = pk2(p[8 * ks + 2], p[8 * ks + 3]); pw.z = pk2(p[8 * ks + 4], p[8 * ks + 5]); pw.w = pk2(p[8 * ks + 6], p[8 * ks + 7]);
            const bf16x8 pb = __builtin_bit_cast(bf16x8, pw);
            { const LAS unsigned short* vr = vts + r32 * 36 + 16 * ks + 4 * hi; const s16x4 lo = *(const LAS s16x4*)vr, hh = *(const LAS s16x4*)(vr + 8);
              const bf16x8 va = __builtin_shufflevector(lo, hh, 0, 1, 2, 3, 4, 5, 6, 7); o0 = MFMA32(va, pb, o0); }
            { const LAS unsigned short* vr = vts + (32 + r32) * 36 + 16 * ks + 4 * hi; const s16x4 lo = *(const LAS s16x4*)vr, hh = *(const LAS s16x4*)(vr + 8);
              const bf16x8 va = __builtin_shufflevector(lo, hh, 0, 1, 2, 3, 4, 5, 6, 7); o1 = MFMA32(va, pb, o1); }
        }
        LDS_WAIT();
        if (__all(R < -160.f)) break;
    }
    bf16* op = QO + (rowQ + qb * 32 + r32) * 1024 + h * 64;
#pragma unroll
    for (int a = 0; a < 4; ++a) {
        v2u w0; w0.x = pk2(o0[4 * a], o0[4 * a + 1]); w0.y = pk2(o0[4 * a + 2], o0[4 * a + 3]); *(v2u*)(op + 8 * a + 4 * hi) = w0;
        v2u w1; w1.x = pk2(o1[4 * a], o1[4 * a + 1]); w1.y = pk2(o1[4 * a + 2], o1[4 * a + 3]); *(v2u*)(op + 32 + 8 * a + 4 * hi) = w1;
    }
}

constexpr int LDP = 136;
template <int MODE> DI void conv_run(const bf16* rowbase, int c, int ch0, int tl0, const float* conv_w, const float* conv_b, LAS bf16* dst, int lc, const LAS float* scale) {
    float w[4][4], bias[4];
#pragma unroll
    for (int k = 0; k < 4; ++k) { const f32x4 a = *(const f32x4*)(conv_w + k * 4096 + ch0); w[k][0] = a.x; w[k][1] = a.y; w[k][2] = a.z; w[k][3] = a.w; }
    { const f32x4 a = *(const f32x4*)(conv_b + ch0); bias[0] = a.x; bias[1] = a.y; bias[2] = a.z; bias[3] = a.w; }
    float win[3][4];
#pragma unroll
    for (int k = 0; k < 3; ++k) { const int t = tl0 - 3 + k; v2u u = (v2u){0u, 0u};
        if (c * 128 + t >= 0) u = *(const v2u*)(rowbase + (long)t * 4096 + ch0);
        win[k][0] = bflo(u.x); win[k][1] = bfhi(u.x); win[k][2] = bflo(u.y); win[k][3] = bfhi(u.y); }
#pragma unroll 1
    for (int sb = 0; sb < 4; ++sb) {
        unsigned pk[4][4]; float hold[4];
#pragma unroll
        for (int tt = 0; tt < 8; ++tt) {
            const int t = tl0 + 8 * sb + tt; const v2u u = *(const v2u*)(rowbase + (long)t * 4096 + ch0);
            float cur[4]; cur[0] = bflo(u.x); cur[1] = bfhi(u.x); cur[2] = bflo(u.y); cur[3] = bfhi(u.y);
            float y[4]; float sc = 1.f; if (MODE == 0) sc = scale[t];
#pragma unroll
            for (int j = 0; j < 4; ++j) { float v = bias[j] + w[0][j] * win[0][j] + w[1][j] * win[1][j] + w[2][j] * win[2][j] + w[3][j] * cur[j];
                v = v * __builtin_amdgcn_rcpf(1.f + __expf(-v)); y[j] = v * sc; }
            if (MODE == 2) { v2u o; o.x = pk2(y[0], y[1]); o.y = pk2(y[2], y[3]); *(LAS v2u*)(dst + t * LDP + lc) = o; }
            else {
#pragma unroll
                for (int j = 0; j < 4; ++j) { if ((tt & 1) == 0) hold[j] = y[j]; else pk[j][tt >> 1] = pk2(hold[j], y[j]); }
            }
#pragma unroll
            for (int j = 0; j < 4; ++j) { win[0][j] = win[1][j]; win[1][j] = win[2][j]; win[2][j] = cur[j]; }
        }
        if (MODE != 2) {
#pragma unroll
            for (int j = 0; j < 4; ++j) { v4u o; o.x = pk[j][0]; o.y = pk[j][1]; o.z = pk[j][2]; o.w = pk[j][3]; *(LAS v4u*)(dst + (lc + j) * LDP + tl0 + 8 * sb) = o; }
        }
    }
}
template <bool WANT_DTE> DI void ssd_acs(Frame& F, const float* DT, int rowfull, int g, LAS float* ACS, LAS float* AUX, float* cd_out) {
    if (F.wave < 4) {
        const int hh = g * 4 + F.wave, l = F.lane; const float a = -__expf(F.A->in[7][hh]);
        const float dtb = F.A->in[6][hh];
        const float x0 = DT[(size_t)(rowfull + 2 * l) * 32 + hh] + dtb, x1 = DT[(size_t)(rowfull + 2 * l + 1) * 32 + hh] + dtb;
        const float dt0 = fmaxf(x0, 0.f) + log1pf(__expf(-fabsf(x0))), dt1 = fmaxf(x1, 0.f) + log1pf(__expf(-fabsf(x1)));
        const float v0 = dt0 * a, v1 = dt1 * a, s = v0 + v1; float incl = s;
#pragma unroll
        for (int o = 1; o < 64; o <<= 1) { const float t = __shfl_up(incl, o); if (l >= o) incl += t; }
        const float excl = incl - s, acs0 = excl + v0, acs1 = incl, tot = __shfl(incl, 63);
        ACS[F.wave * 128 + 2 * l] = acs0; ACS[F.wave * 128 + 2 * l + 1] = acs1;
        if (WANT_DTE) { AUX[F.wave * 128 + 2 * l] = dt0 * __expf(tot - acs0); AUX[F.wave * 128 + 2 * l + 1] = dt1 * __expf(tot - acs1); if (l == 63) cd_out[hh] = __expf(tot); }
        else { AUX[F.wave * 128 + 2 * l] = dt0; AUX[F.wave * 128 + 2 * l + 1] = dt1; }
    }
}
DI void ssd_states_unit(Frame& F, int hb, int bl, int c, int g) {
    LAS bf16* XST = (LAS bf16*)F.lds; LAS bf16* BT = (LAS bf16*)(F.lds + 69632); LAS float* ACS = (LAS float*)(F.lds + 104448); LAS float* DTE = (LAS float*)(F.lds + 106496);
    const int rowfull = hb * MH + bl * SEQ + c * 128;
    const bf16* rowbase = (const bf16*)(F.ws + WS_XBC) + (size_t)(bl * SEQ + c * 128) * 4096;
    float* CD = (float*)(F.ws + WS_CD) + (bl * 32 + c) * 32;
    ssd_acs<true>(F, (const float*)(F.ws + WS_DT), rowfull, g, ACS, DTE, CD);
    __syncthreads();
    if (F.tid < 384) { const int cgi = F.tid % 96, tr = F.tid / 96;
        if (cgi < 64) conv_run<0>(rowbase, c, g * 256 + 4 * cgi, 32 * tr, F.A->in[4], F.A->in[5], XST, 4 * cgi, DTE + (cgi >> 4) * 128);
        else conv_run<1>(rowbase, c, 2048 + g * 128 + 4 * (cgi - 64), 32 * tr, F.A->in[4], F.A->in[5], BT, 4 * (cgi - 64), nullptr); }
    __syncthreads();
    const int r32 = F.lane & 31, hi = F.lane >> 5, hl = F.wave >> 1, pt = F.wave & 1;
    f32x16 acc[4];
#pragma unroll
    for (int nt = 0; nt < 4; ++nt)
#pragma unroll
        for (int i = 0; i < 16; ++i) acc[nt][i] = 0.f;
#pragma unroll
    for (int ks = 0; ks < 8; ++ks) { const bf16x8 xf = *(const LAS bf16x8*)(XST + (hl * 64 + pt * 32 + r32) * LDP + 16 * ks + 8 * hi);
#pragma unroll
        for (int nt = 0; nt < 4; ++nt) { const bf16x8 bfr = *(const LAS bf16x8*)(BT + (32 * nt + r32) * LDP + 16 * ks + 8 * hi); acc[nt] = MFMA32(bfr, xf, acc[nt]); } }
    bf16* st = (bf16*)((unsigned char*)F.out + DO_ST) + ((size_t)((bl * 32 + c) * 32 + g * 4 + hl) * 64 + 32 * pt + r32) * 128;
#pragma unroll
    for (int nt = 0; nt < 4; ++nt)
#pragma unroll
        for (int a = 0; a < 4; ++a) { v2u w; w.x = pk2(acc[nt][4 * a], acc[nt][4 * a + 1]); w.y = pk2(acc[nt][4 * a + 2], acc[nt][4 * a + 3]); *(v2u*)(st + 32 * nt + 8 * a + 4 * hi) = w; }
    __syncthreads();
}
DI void ssd_scan(Frame& F) {
    bf16* ST = (bf16*)((unsigned char*)F.out + DO_ST); const float* CD = (const float*)(F.ws + WS_CD);
    for (int e = F.bid * 512 + F.tid; e < 262144; e += F.G * 512) {
        const int n2 = e & 63, p = (e >> 6) & 63, h = (e >> 12) & 31, bl = e >> 17;
        unsigned* base = (unsigned*)(ST + ((size_t)(bl * 1024 + h) * 64 + p) * 128 + 2 * n2);
        unsigned v[32];
#pragma unroll
        for (int c = 0; c < 32; ++c) v[c] = base[(size_t)c * 131072];
        float p0 = 0.f, p1 = 0.f;
#pragma unroll
        for (int c = 0; c < 32; ++c) { const float dec = CD[(bl * 32 + c) * 32 + h]; base[(size_t)c * 131072] = pk2(p0, p1); p0 = p0 * dec + bflo(v[c]); p1 = p1 * dec + bfhi(v[c]); }
    }
}
DI void ssd_final_unit(Frame& F, int hb, int bl, int c, int g) {
    LAS bf16* XST = (LAS bf16*)F.lds; LAS bf16* BM = (LAS bf16*)(F.lds + 69632); LAS bf16* CM = (LAS bf16*)(F.lds + 104448);
    LAS float* ACS = (LAS float*)(F.lds + 139264); LAS float* DTS = (LAS float*)(F.lds + 141312); LAS float* NRM = (LAS float*)(F.lds + 143360);
    const int rowfull = hb * MH + bl * SEQ + c * 128;
    const bf16* rowbase = (const bf16*)(F.ws + WS_XBC) + (size_t)(bl * SEQ + c * 128) * 4096;
    ssd_acs<false>(F, (const float*)(F.ws + WS_DT), rowfull, g, ACS, DTS, nullptr);
    { const int cgi = F.tid & 127, tr = F.tid >> 7;
      if (cgi < 64) conv_run<1>(rowbase, c, g * 256 + 4 * cgi, 32 * tr, F.A->in[4], F.A->in[5], XST, 4 * cgi, nullptr);
      else if (cgi < 96) conv_run<2>(rowbase, c, 2048 + g * 128 + 4 * (cgi - 64), 32 * tr, F.A->in[4], F.A->in[5], BM, 4 * (cgi - 64), nullptr);
      else conv_run<2>(rowbase, c, 3072 + g * 128 + 4 * (cgi - 96), 32 * tr, F.A->in[4], F.A->in[5], CM, 4 * (cgi - 96), nullptr); }
    __syncthreads();
    const int r32 = F.lane & 31, hi = F.lane >> 5, lt = F.wave >> 1, hp = F.wave & 1;
    const int l = 32 * lt + r32;
    bf16x8 cf[8];
#pragma unroll
    for (int ks = 0; ks < 8; ++ks) cf[ks] = *(const LAS bf16x8*)(CM + l * LDP + 16 * ks + 8 * hi);
    f32x16 acc[2][2];
#pragma unroll
    for (int hd = 0; hd < 2; ++hd)
#pragma unroll
        for (int pt = 0; pt < 2; ++pt)
#pragma unroll
            for (int i = 0; i < 16; ++i) acc[hd][pt][i] = 0.f;
    const bf16* PV = (const bf16*)((const unsigned char*)F.out + DO_ST);
#pragma unroll
    for (int hd = 0; hd < 2; ++hd) { const int head = g * 4 + 2 * hp + hd;
#pragma unroll
        for (int pt = 0; pt < 2; ++pt) { const bf16* pp = PV + ((size_t)((bl * 32 + c) * 32 + head) * 64 + 32 * pt + r32) * 128 + 8 * hi;
#pragma unroll
            for (int ks = 0; ks < 8; ++ks) { const bf16x8 pf = *(const bf16x8*)(pp + 16 * ks); acc[hd][pt] = MFMA32(pf, cf[ks], acc[hd][pt]); } }
        const float el = __expf(ACS[(2 * hp + hd) * 128 + l]);
#pragma unroll
        for (int pt = 0; pt < 2; ++pt)
#pragma unroll
            for (int i = 0; i < 16; ++i) acc[hd][pt][i] *= el; }
    for (int st = 0; st <= lt; ++st) {
        f32x16 cb;
#pragma unroll
        for (int i = 0; i < 16; ++i) cb[i] = 0.f;
#pragma unroll
        for (int ks = 0; ks < 8; ++ks) { const bf16x8 bfr = *(const LAS bf16x8*)(BM + (32 * st + r32) * LDP + 16 * ks + 8 * hi); cb = MFMA32(bfr, cf[ks], cb); }
#pragma unroll
        for (int hd = 0; hd < 2; ++hd) { const int hl = 2 * hp + hd; const float al = ACS[hl * 128 + l]; const float dsk = F.A->in[8][g * 4 + hl];
            float mv[16];
#pragma unroll
            for (int a = 0; a < 4; ++a) { const int s0 = 32 * st + 8 * a + 4 * hi; const f32x4 as = *(const LAS f32x4*)(ACS + hl * 128 + s0), ds = *(const LAS f32x4*)(DTS + hl * 128 + s0);
#pragma unroll
                for (int j = 0; j < 4; ++j) { const int s = s0 + j; float m = cb[4 * a + j] * __expf(fminf(al - as[j], 0.f)) * ds[j]; m = (s <= l) ? m : 0.f; m += (s == l) ? dsk : 0.f; mv[4 * a + j] = m; } }
#pragma unroll
            for (int ks2 = 0; ks2 < 2; ++ks2) { v4u mw; mw.x = pk2(mv[8 * ks2], mv[8 * ks2 + 1]); mw.y = pk2(mv[8 * ks2 + 2], mv[8 * ks2 + 3]); mw.z = pk2(mv[8 * ks2 + 4], mv[8 * ks2 + 5]); mw.w = pk2(mv[8 * ks2 + 6], mv[8 * ks2 + 7]);
                const bf16x8 mb = __builtin_bit_cast(bf16x8, mw);
#pragma unroll
                for (int pt = 0; pt < 2; ++pt) { const LAS bf16* xr = XST + (hl * 64 + 32 * pt + r32) * LDP + 32 * st + 16 * ks2 + 4 * hi;
                    const s16x4 lo = *(const LAS s16x4*)xr, hh = *(const LAS s16x4*)(xr + 8); const bf16x8 xa = __builtin_shufflevector(lo, hh, 0, 1, 2, 3, 4, 5, 6, 7);
                    acc[hd][pt] = MFMA32(xa, mb, acc[hd][pt]); } } }
    }
    bf16* yrow = (bf16*)(F.ws + WS_YS) + (size_t)(rowfull + l) * 2048 + g * 256;
    float ss = 0.f;
#pragma unroll
    for (int hd = 0; hd < 2; ++hd)
#pragma unroll
        for (int pt = 0; pt < 2; ++pt)
#pragma unroll
            for (int a = 0; a < 4; ++a) { const v2u zz = *(const v2u*)(yrow + (2 * hp + hd) * 64 + 32 * pt + 8 * a + 4 * hi);
                const float z0 = bflo(zz.x), z1 = bfhi(zz.x), z2 = bflo(zz.y), z3 = bfhi(zz.y);
                float y0 = acc[hd][pt][4 * a] * z0 * sigm(z0), y1 = acc[hd][pt][4 * a + 1] * z1 * sigm(z1), y2 = acc[hd][pt][4 * a + 2] * z2 * sigm(z2), y3 = acc[hd][pt][4 * a + 3] * z3 * sigm(z3);
                acc[hd][pt][4 * a] = y0; acc[hd][pt][4 * a + 1] = y1; acc[hd][pt][4 * a + 2] = y2; acc[hd][pt][4 * a + 3] = y3; ss += (y0 * y0 + y1 * y1) + (y2 * y2 + y3 * y3); }
    ss += __shfl_xor(ss, 32);
    if (hi == 0) NRM[F.wave * 32 + r32] = ss;
    __syncthreads();
    const float tot = NRM[(2 * lt) * 32 + r32] + NRM[(2 * lt + 1) * 32 + r32];
    const float rs = rsqrtf(tot * (1.f / 256.f) + RMS_EPS);
    const float* nw = F.A->in[9] + g * 256;
#pragma unroll
    for (int hd = 0; hd < 2; ++hd)
#pragma unroll
        for (int pt = 0; pt < 2; ++pt)
#pragma unroll
            for (int a = 0; a < 4; ++a) { const int ch = (2 * hp + hd) * 64 + 32 * pt + 8 * a + 4 * hi; const f32x4 wv = *(const f32x4*)(nw + ch);
                v2u o; o.x = pk2(acc[hd][pt][4 * a] * rs * wv.x, acc[hd][pt][4 * a + 1] * rs * wv.y); o.y = pk2(acc[hd][pt][4 * a + 2] * rs * wv.z, acc[hd][pt][4 * a + 3] * rs * wv.w);
                *(v2u*)(yrow + ch) = o; }
    __syncthreads();
}

template <int MODE> DI void norm_rows(Frame& F, const float* src, const float* w1, const float* w2, bf16* ob) {
    const int gw = F.bid * 8 + F.wave, NGW = F.G * 8, lane = F.lane;
    for (int m = gw; m < M; m += NGW) {
        const f32x4* sr = (const f32x4*)(src + (size_t)m * DM); const f32x4* br = (const f32x4*)((MODE == 0 ? F.A->in[0] : F.out) + (size_t)m * DM);
        f32x4 v[4], b[4]; float s = 0.f;
#pragma unroll
        for (int j = 0; j < 4; ++j) { v[j] = sr[lane + 64 * j]; b[j] = br[lane + 64 * j]; s += (v[j].x * v[j].x + v[j].y * v[j].y) + (v[j].z * v[j].z + v[j].w * v[j].w); }
        const float r = rsqrtf(wave_sum(s) * (1.f / 1024.f) + RMS_EPS); float s2 = 0.f;
#pragma unroll
        for (int j = 0; j < 4; ++j) { const f32x4 wv = ((const f32x4*)w1)[lane + 64 * j]; v[j] = b[j] + v[j] * r * wv; ((f32x4*)(F.out + (size_t)m * DM))[lane + 64 * j] = v[j];
            s2 += (v[j].x * v[j].x + v[j].y * v[j].y) + (v[j].z * v[j].z + v[j].w * v[j].w); }
        if (MODE == 0) { const float r2 = rsqrtf(wave_sum(s2) * (1.f / 1024.f) + RMS_EPS);
#pragma unroll
            for (int j = 0; j < 4; ++j) { const f32x4 wv = ((const f32x4*)w2)[lane + 64 * j]; v2u o; o.x = pk2(v[j].x * r2 * wv.x, v[j].y * r2 * wv.y); o.y = pk2(v[j].z * r2 * wv.z, v[j].w * r2 * wv.w);
                ((v2u*)(ob + (size_t)m * DM))[lane + 64 * j] = o; } }
        if (MODE == 1) {
#pragma unroll
            for (int j = 0; j < 4; ++j) { v2u o; o.x = pk2(v[j].x, v[j].y); o.y = pk2(v[j].z, v[j].w); ((v2u*)(ob + (size_t)m * DM))[lane + 64 * j] = o; } }
    }
}

__global__ void __launch_bounds__(512, 2) fwd_megakernel(Args args) {
    extern __shared__ __attribute__((aligned(16))) unsigned char lds_raw[];
    Frame F; F.lds = (LAS unsigned char*)lds_raw; F.tid = threadIdx.x; F.lane = F.tid & 63; F.wave = __builtin_amdgcn_readfirstlane(F.tid >> 6); F.G = gridDim.x; F.bid = blockIdx.x;
    F.A = (const __attribute__((address_space(4))) Args*)__builtin_amdgcn_kernarg_segment_ptr();
    F.out = F.A->out; F.ws = F.A->ws;
    volatile LAS unsigned* MISC = (volatile LAS unsigned*)(F.lds + MISC_OFF);
    if (F.tid < 32) MISC[F.tid] = 0u;
    __syncthreads();
    XcdBarrier bar = xcd_barrier_post((unsigned*)(F.ws + WS_CTL), MISC + 8);
#define LAUNDER() asm volatile("" : "+s"(F.A), "+v"(F.tid), "+v"(F.lane), "+s"(F.wave), "+s"(F.bid))
#define GRID_BAR() do { xcd_barrier(bar); LAUNDER(); } while (0)
    unsigned char* ws = F.ws; unsigned char* ob = (unsigned char*)F.out;
    bf16* XN = (bf16*)(ws + WS_XN); bf16* YS = (bf16*)(ws + WS_YS); bf16* YSB = (bf16*)(ws + WS_YSB);

#ifndef SKIP_P0
    p0_prologue(F);
#endif
    cg::this_grid().sync();
    LAUNDER();

    for (int hb = 0; hb < 2; ++hb) {
#ifndef SKIP_G1
        {
            pg8::Gemm g{XN + (size_t)hb * MH * DM, (const bf16*)(ws + WS_W1), MH, N1, DM}; pg8::StaticOrder S; S.init(MH, N1, F.G, F.bid);
            Epi1 E{YS, (bf16*)(ws + WS_XBC), YSB, (bf16*)(ob + DO_K), (bf16*)(ob + DO_V), (float*)(ws + WS_DT), F.A->in[6], hb * MH};
            pg8::gemm_phase<Epi1, pg8::StaticOrder, true, true>(F.lds, g, S, E);
        }
#endif

        GRID_BAR();
        {
            LAS unsigned short* vts = (LAS unsigned short*)(F.lds + F.wave * 4608);
#ifndef SKIP_ATT
            for (int u = F.bid * 8 + F.wave; u < 4096; u += F.G * 8) { const int qb = 127 - (u & 127), h = (u >> 7) & 15, bl = u >> 11;
                attn_wave_unit(YSB, (const bf16*)(ob + DO_K), (const bf16*)(ob + DO_V), hb, bl, h, qb, vts, F.lane); }
#endif
            __syncthreads();
            LAUNDER();
#ifndef SKIP_P2
            for (int u = F.bid; u < 512; u += F.G) { const int g = u & 7, c = (u >> 3) & 31, bl = u >> 8; ssd_states_unit(F, hb, bl, c, g); }
#endif
        }
        GRID_BAR();
#ifndef SKIP_SCAN
        ssd_scan(F);
#endif
        GRID_BAR();
#ifndef SKIP_P3
        for (int u = F.bid; u < 512; u += F.G) { const int g = u & 7, c = (u >> 3) & 31, bl = u >> 8; ssd_final_unit(F, hb, bl, c, g); }
#endif
        GRID_BAR();
    }
    float* MRG = (float*)ob; float* T2 = (float*)(ws + WS_T2);
#ifndef SKIP_M1
    {
        pg8::StaticOrder S; S.init(M, DM, F.G, F.bid);
        { pg8::Gemm g{YS, (const bf16*)(ws + WS_WSSD), M, DM, 2048}; EpiF<0> E{MRG, nullptr, nullptr, nullptr, nullptr}; pg8::gemm_phase<EpiF<0>, pg8::StaticOrder, true, true>(F.lds, g, S, E); }
        { pg8::Gemm g{YSB, (const bf16*)(ws + WS_WSB), M, DM, DM}; EpiF<0> E{T2, nullptr, nullptr, nullptr, nullptr}; pg8::gemm_phase<EpiF<0>, pg8::StaticOrder, true, true>(F.lds, g, S, E); }
    }
#endif

    GRID_BAR();
#ifndef SKIP_M2
    {
        pg8::StaticOrder S; S.init(M, DM, F.G, F.bid);
        { pg8::Gemm g{XN, (const bf16*)(ws + WS_WG), M, DM, DM}; EpiF<1> E{MRG, F.A->in[13], nullptr, nullptr, nullptr}; pg8::gemm_phase<EpiF<1>, pg8::StaticOrder, true, true>(F.lds, g, S, E); }
        { pg8::Gemm g{XN, (const bf16*)(ws + WS_WG) + (size_t)1024 * 1024, M, DM, DM}; EpiF<2> E{nullptr, F.A->in[13] + 1024, MRG, T2, (bf16*)(ws + WS_MG)}; pg8::gemm_phase<EpiF<2>, pg8::StaticOrder, true, true>(F.lds, g, S, E); }
    }
#endif

    GRID_BAR();
#ifndef SKIP_WOUT
    { pg8::StaticOrder S; S.init(M, DM, F.G, F.bid); pg8::Gemm g{(const bf16*)(ws + WS_MG), (const bf16*)(ws + WS_WOUT), M, DM, DM}; EpiF<0> E{(float*)(ws + WS_MO), nullptr, nullptr, nullptr, nullptr};
      pg8::gemm_phase<EpiF<0>, pg8::StaticOrder, true, true>(F.lds, g, S, E); }
#endif

    GRID_BAR();
    norm_rows<0>(F, (const float*)(ws + WS_MO), F.A->in[15], F.A->in[16], (bf16*)(ws + WS_N2));
    GRID_BAR();
#ifndef SKIP_FF1
    { pg8::StaticOrder S; S.init(M, DFF, F.G, F.bid); pg8::Gemm g{(const bf16*)(ws + WS_N2), (const bf16*)(ws + WS_WFF1), M, DFF, DM}; EpiRelu2 E{(bf16*)(ws + WS_HID)};
      pg8::gemm_phase<EpiRelu2, pg8::StaticOrder, true, true>(F.lds, g, S, E); }
#endif

    GRID_BAR();
#ifndef SKIP_FF2
    { pg8::StaticOrder S; S.init(M, DM, F.G, F.bid); pg8::Gemm g{(const bf16*)(ws + WS_HID), (const bf16*)(ws + WS_WFF2), M, DM, DFF}; EpiF<0> E{(float*)(ws + WS_FO), nullptr, nullptr, nullptr, nullptr};
      pg8::gemm_phase<EpiF<0>, pg8::StaticOrder, true, true>(F.lds, g, S, E); }
#endif

    GRID_BAR();
    norm_rows<1>(F, (const float*)(ws + WS_FO), F.A->in[19], nullptr, (bf16*)(ws + WS_H2B));
    {
        const f32x4* ps = (const f32x4*)F.A->in[1]; v2u* pd = (v2u*)(ws + WS_PB);
        for (int i = F.bid * 512 + F.tid; i < M * 256 / 4; i += F.G * 512) { const f32x4 v = ps[i]; v2u o; o.x = pk2(v.x, v.y); o.y = pk2(v.z, v.w); pd[i] = o; }
    }
    GRID_BAR();
#ifndef SKIP_PLE
    {
        pg8::StaticOrder S; S.init(M, DM, F.G, F.bid); float* PL = (float*)(ws + WS_PL);
        { pg8::Gemm g{(const bf16*)(ws + WS_PB), (const bf16*)(ws + WS_WPLE), M, DM, 256}; EpiF<0> E{PL, nullptr, nullptr, nullptr, nullptr}; pg8::gemm_phase<EpiF<0>, pg8::StaticOrder, true, true>(F.lds, g, S, E); }
        { pg8::Gemm g{(const bf16*)(ws + WS_H2B), (const bf16*)(ws + WS_WPG), M, DM, DM}; EpiF<1> E{PL, nullptr, nullptr, nullptr, nullptr}; pg8::gemm_phase<EpiF<1>, pg8::StaticOrder, true, true>(F.lds, g, S, E); }
    }
#endif

    GRID_BAR();
    norm_rows<2>(F, (const float*)(ws + WS_PL), F.A->in[22], nullptr, nullptr);
}

extern "C" void kernel_launch(void* const* d_in, const int* in_sizes, int n_in, void* d_out, int out_size, void* d_ws, size_t ws_size, hipStream_t stream) {
    static int grid = 0;
    if (grid == 0) {
        int dev = 0, cus = 0, per_cu = 0;
        (void)hipGetDevice(&dev); (void)hipDeviceGetAttribute(&cus, hipDeviceAttributeMultiprocessorCount, dev);
        (void)hipFuncSetAttribute((const void*)fwd_megakernel, hipFuncAttributeMaxDynamicSharedMemorySize, LDS_TOTAL);
        if (hipOccupancyMaxActiveBlocksPerMultiprocessor(&per_cu, (const void*)fwd_megakernel, 512, LDS_TOTAL) != hipSuccess || per_cu < 1) per_cu = 1;
        (void)hipGetLastError();
        grid = cus * (per_cu > 1 ? 1 : per_cu);
        if (n_in != 23 || ws_size < 256 * MiB) fprintf(stderr, "kernel_launch: unexpected n_in %d / ws_size %zu\n", n_in, ws_size);
    }
    (void)hipMemsetAsync((char*)d_ws + WS_CTL, 0, CTL_BYTES, stream);
    Args a{};
    for (int i = 0; i < 23; ++i) a.in[i] = (const float*)d_in[i];
    a.out = (float*)d_out; a.ws = (unsigned char*)d_ws;
    void* kargs[] = {&a};
    hipError_t e = hipLaunchCooperativeKernel((const void*)fwd_megakernel, dim3(grid), dim3(512), kargs, LDS_TOTAL, stream);
    if (e != hipSuccess) fprintf(stderr, "cooperative launch failed: %s (grid %d)\n", hipGetErrorString(e), grid);
}
```

```cpp
#include <hip/hip_runtime.h>
#include <hip/hip_cooperative_groups.h>
#include <cstdio>
#include <cstdint>
#include <cmath>
namespace cg = cooperative_groups;
#define GAS __attribute__((address_space(1)))
#define LAS __attribute__((address_space(3)))
typedef unsigned short bf16;
typedef unsigned v4u __attribute__((ext_vector_type(4)));
typedef float f32x4 __attribute__((ext_vector_type(4)));
typedef short bf16x8 __attribute__((ext_vector_type(8)));
namespace pg8 {
#define PG8_LAS __attribute__((address_space(3)))
typedef unsigned short bf16_t;
typedef short bf16x8 __attribute__((ext_vector_type(8)));
typedef float f32x4 __attribute__((ext_vector_type(4)));
typedef unsigned u32x4 __attribute__((ext_vector_type(4)));
constexpr int BM = 256, BK = 64, HALF = 128, HTB = HALF * BK * 2  , STAGE_BYTES = 8 * HTB, NXCD = 8, WGM = 8;

__host__ __device__ __forceinline__ int lds_byte(int r, int c) { const int st = (r >> 4) * 2 + (c >> 5), rr = r & 15, cc = c & 31, ob = rr * 64 + cc * 2; return st * 1024 + (ob ^ (((ob >> 9) & 1) << 5)); }
__host__ __device__ __forceinline__ void stage_rc(int b, int& R, int& C) { const int st = b / 1024, sb = b % 1024, swz = sb ^ (((sb >> 9) & 1) << 5); R = (st >> 1) * 16 + swz / 64; C = (st & 1) * 32 + (swz % 64) / 2; }
__host__ __device__ __forceinline__ int perm32(int rho) { const int n = rho >> 4, i = rho & 15; return 8 * (i >> 2) + 4 * n + (i & 3); }

struct Unit { int pm, pn; };
struct Gemm { const bf16_t* A; const bf16_t* Bt; int M, N, K; };

struct StaticOrder {
    int nM, nN, nwg, G, c;
    __host__ __device__ void init(int M, int N, int G_, int c_) { nM = M / BM; nN = N / BM; nwg = nM * nN; G = G_; c = c_; }
    __host__ __device__ bool next(int i, Unit& u) const {
        const long L = (long)i * G + c; if (L >= nwg) return false;
        int wgid = (int)L; { const int q = nwg / NXCD, r = nwg % NXCD, xcd = wgid % NXCD, off = wgid / NXCD; wgid = (xcd < r ? xcd * (q + 1) : r * (q + 1) + (xcd - r) * q) + off; }
        const int nig = WGM * nN, gid = wgid / nig, fm = gid * WGM, gsz = (nM - fm) < WGM ? (nM - fm) : WGM;
        u.pm = fm + ((wgid % nig) % gsz); u.pn = (wgid % nig) / gsz; return true;
    }
    __device__ __forceinline__ void a_ready(const Unit&) const {}
    __device__ __forceinline__ void done(const Unit&) const {}
};

template <class Epi, class Sched, bool ALIGN_EPI = false, bool SP2 = false>
__device__ __forceinline__ void gemm_phase(PG8_LAS unsigned char* lds, const Gemm g, const Sched& S, const Epi& E) {
    const int tid = threadIdx.x, wid = __builtin_amdgcn_readfirstlane(tid >> 6), lane = tid & 63, wr = wid >> 2, wc = wid & 3, fr = lane & 15, fq = lane >> 4;
    const int K = g.K, nt = K / BK;
    unsigned voffA[2], voffB[2];
#pragma unroll
    for (int i = 0; i < 2; ++i) { int R, C; stage_rc(tid * 16 + i * 8192, R, C); const int Rb = Epi::PERM ? ((R & ~31) + perm32(R & 31)) : R;
        voffA[i] = (unsigned)(R * K + C) * 2u; voffB[i] = (unsigned)(Rb * K + C) * 2u; }
    const size_t kstep = (size_t)(BK * 2);
    const size_t hstep = (size_t)HALF * K * 2;
    const size_t tstep = 2 * hstep;
    const unsigned ldsw = (unsigned)wid * 1024u;
    const int aoff = lds_byte(wr * 64 + fr, fq * 8), boff = lds_byte(wc * 32 + fr, fq * 8);
#define PG8_SA(b, h) (((b) * 2 + (h)) * HTB)
#define PG8_SB(b, h) ((4 + (b) * 2 + (h)) * HTB)
#define PG8_STAGE(bufoff, gbase, voff) do { _Pragma("unroll") for (int _i = 0; _i < 2; ++_i) \
        __builtin_amdgcn_global_load_lds((const unsigned*)((const char*)(gbase) + (voff)[_i]), (PG8_LAS unsigned*)(lds + (bufoff) + ldsw + _i * 8192), 16, 0, 0); } while (0)
#define PG8_LDA(dst, b, h) do { _Pragma("unroll") for (int m = 0; m < 4; ++m) _Pragma("unroll") for (int k = 0; k < 2; ++k) dst[m][k] = *(const PG8_LAS bf16x8*)(lds + PG8_SA(b, h) + aoff + m * 2048 + k * 1024); } while (0)
#define PG8_LDB(dst, b, h) do { _Pragma("unroll") for (int n = 0; n < 2; ++n) _Pragma("unroll") for (int k = 0; k < 2; ++k) dst[n][k] = *(const PG8_LAS bf16x8*)(lds + PG8_SB(b, h) + boff + n * 2048 + k * 1024); } while (0)
#define PG8_MMA(ai, bj, At, Bt) do { __builtin_amdgcn_s_setprio(1); _Pragma("unroll") for (int m = 0; m < 4; ++m) _Pragma("unroll") for (int n = 0; n < 2; ++n) _Pragma("unroll") for (int k = 0; k < 2; ++k) \
        acc[ai][bj][m][n] = __builtin_amdgcn_mfma_f32_16x16x32_bf16(Bt[n][k], At[m][k], acc[ai][bj][m][n], 0, 0, 0); __builtin_amdgcn_s_setprio(0); } while (0)
#define PG8_WAIT_V(n) asm volatile("s_waitcnt vmcnt(" #n ")" ::: "memory")
#define PG8_WAIT_L(n) asm volatile("s_waitcnt lgkmcnt(" #n ")" ::: "memory")
#define PG8_BAR __builtin_amdgcn_s_barrier()
#define PG8_SCHED __builtin_amdgcn_sched_barrier(0)
    Unit cur, nxt; int ui = 0;
    if (!S.next(0, cur)) return;
    f32x4 acc[2][2][4][2];
#pragma unroll
    for (int a = 0; a < 2; ++a)
#pragma unroll
        for (int b = 0; b < 2; ++b)
#pragma unroll
            for (int m = 0; m < 4; ++m)
#pragma unroll
                for (int n = 0; n < 2; ++n) acc[a][b][m][n] = (f32x4){0.f, 0.f, 0.f, 0.f};
    bf16x8 At[4][2], B0[2][2], B1[2][2];
    const char* cA = (const char*)g.A + (size_t)cur.pm * tstep; const char* cB = (const char*)g.Bt + (size_t)cur.pn * tstep;
    S.a_ready(cur);
    if constexpr (SP2) {
        PG8_STAGE(PG8_SB(0, 0), cB, voffB); PG8_STAGE(PG8_SB(0, 1), cB + hstep, voffB); PG8_STAGE(PG8_SA(0, 0), cA, voffA); PG8_STAGE(PG8_SA(0, 1), cA + hstep, voffA);
        if (wr == 1) PG8_BAR;
        PG8_WAIT_V(2); PG8_BAR;
        PG8_STAGE(PG8_SB(1, 0), cB + kstep, voffB); PG8_STAGE(PG8_SA(1, 0), cA + kstep, voffA); PG8_STAGE(PG8_SB(1, 1), cB + hstep + kstep, voffB);
        PG8_WAIT_V(6); PG8_BAR;
    } else {
        PG8_STAGE(PG8_SB(0, 0), cB, voffB); PG8_STAGE(PG8_SA(0, 0), cA, voffA); PG8_STAGE(PG8_SB(0, 1), cB + hstep, voffB); PG8_STAGE(PG8_SA(0, 1), cA + hstep, voffA);
        if (wr == 1) PG8_BAR;
        PG8_WAIT_V(4); PG8_BAR;
        PG8_STAGE(PG8_SB(1, 0), cB + kstep, voffB); PG8_STAGE(PG8_SA(1, 0), cA + kstep, voffA); PG8_STAGE(PG8_SB(1, 1), cB + hstep + kstep, voffB);
        PG8_WAIT_V(6); PG8_BAR;
    }
    for (;;) {
        const bool has_next = S.next(ui + 1, nxt);
        const char* nA = has_next ? (const char*)g.A + (size_t)nxt.pm * tstep : cA; const char* nB = has_next ? (const char*)g.Bt + (size_t)nxt.pn * tstep : cB;
        for (int t = 0; t < nt; t += 2) {
            const bool last = (t == nt - 2);
            const char* a1 = cA + (size_t)(t + 1) * kstep;
            const char* a2 = last ? nA : cA + (size_t)(t + 2) * kstep; const char* b2 = last ? nB : cB + (size_t)(t + 2) * kstep;
            const char* a3 = a2 + kstep; const char* b3 = b2 + kstep;
            if (last && has_next) S.a_ready(nxt);
            if constexpr (SP2) {
            PG8_LDB(B0, 0, 0); PG8_LDB(B1, 0, 1); PG8_SCHED; PG8_LDA(At, 0, 0); PG8_STAGE(PG8_SA(1, 1), a1 + hstep, voffA);
            PG8_WAIT_V(8); PG8_WAIT_L(0); PG8_BAR; PG8_MMA(0, 0, At, B0); PG8_MMA(0, 1, At, B1); PG8_BAR; PG8_SCHED;
            PG8_LDA(At, 0, 1); PG8_STAGE(PG8_SB(0, 0), b2, voffB); PG8_STAGE(PG8_SB(0, 1), b2 + hstep, voffB); PG8_STAGE(PG8_SA(0, 0), a2, voffA);
            PG8_WAIT_V(8); PG8_WAIT_L(0); PG8_BAR; PG8_MMA(1, 0, At, B0); PG8_MMA(1, 1, At, B1); PG8_BAR; PG8_SCHED;
            PG8_LDB(B0, 1, 0); PG8_LDB(B1, 1, 1); PG8_SCHED; PG8_LDA(At, 1, 0); PG8_STAGE(PG8_SA(0, 1), a2 + hstep, voffA);
            PG8_WAIT_V(8); PG8_WAIT_L(0); PG8_BAR; PG8_MMA(0, 0, At, B0); PG8_MMA(0, 1, At, B1); PG8_BAR; PG8_SCHED;
            PG8_LDA(At, 1, 1); PG8_STAGE(PG8_SB(1, 0), b3, voffB); PG8_STAGE(PG8_SB(1, 1), b3 + hstep, voffB); PG8_STAGE(PG8_SA(1, 0), a3, voffA);
            PG8_WAIT_V(8); PG8_WAIT_L(0); PG8_BAR; PG8_MMA(1, 0, At, B0); PG8_MMA(1, 1, At, B1); PG8_BAR; PG8_SCHED;
            } else {
            PG8_LDB(B0, 0, 0); PG8_SCHED; PG8_LDA(At, 0, 0); PG8_STAGE(PG8_SA(1, 1), a1 + hstep, voffA);
            PG8_WAIT_L(8); PG8_BAR; PG8_WAIT_L(0); PG8_MMA(0, 0, At, B0); PG8_BAR; PG8_SCHED;
            PG8_LDB(B1, 0, 1); PG8_STAGE(PG8_SB(0, 0), b2, voffB);
            PG8_BAR; PG8_WAIT_L(0); PG8_MMA(0, 1, At, B1); PG8_BAR;
            PG8_LDA(At, 0, 1); PG8_STAGE(PG8_SA(0, 0), a2, voffA);
            PG8_BAR; PG8_WAIT_L(0); PG8_MMA(1, 0, At, B0); PG8_BAR; PG8_SCHED;
            PG8_STAGE(PG8_SB(0, 1), b2 + hstep, voffB);
            PG8_WAIT_V(6); PG8_BAR; PG8_MMA(1, 1, At, B1); PG8_BAR;
            PG8_LDB(B0, 1, 0); PG8_SCHED; PG8_LDA(At, 1, 0); PG8_STAGE(PG8_SA(0, 1), a2 + hstep, voffA);
            PG8_WAIT_L(8); PG8_BAR; PG8_WAIT_L(0); PG8_MMA(0, 0, At, B0); PG8_BAR; PG8_SCHED;
            PG8_LDB(B1, 1, 1); PG8_STAGE(PG8_SB(1, 0), b3, voffB);
            PG8_BAR; PG8_WAIT_L(0); PG8_MMA(0, 1, At, B1); PG8_BAR;
            PG8_LDA(At, 1, 1); PG8_STAGE(PG8_SA(1, 0), a3, voffA);
            PG8_BAR; PG8_WAIT_L(0); PG8_MMA(1, 0, At, B0); PG8_BAR; PG8_SCHED;
            PG8_STAGE(PG8_SB(1, 1), b3 + hstep, voffB);
            PG8_WAIT_V(6); PG8_BAR; PG8_MMA(1, 1, At, B1); PG8_BAR;
            }
        }
        if constexpr (ALIGN_EPI) { if (wr == 0) PG8_BAR; }
        if constexpr (!Epi::AFTER_DRAIN) { E(acc, cur, wr, wc, fr, fq); S.done(cur); }
        if (!has_next) break;
#pragma unroll
        for (int a = 0; a < 2; ++a)
#pragma unroll
            for (int b = 0; b < 2; ++b)
#pragma unroll
                for (int m = 0; m < 4; ++m)
#pragma unroll
                    for (int n = 0; n < 2; ++n) acc[a][b][m][n] = (f32x4){0.f, 0.f, 0.f, 0.f};
        cur = nxt; cA = nA; cB = nB; ++ui;
        if constexpr (ALIGN_EPI) { if (wr == 1) PG8_BAR; }
    }
    PG8_WAIT_V(0);
    if constexpr (!ALIGN_EPI) { if (wr == 0) PG8_BAR; }
    PG8_BAR;
    if constexpr (Epi::AFTER_DRAIN) { E.fused(acc, cur, wr, wc, fr, fq, lds, wid, lane); S.done(cur); }
#undef PG8_SA
#undef PG8_SB
#undef PG8_STAGE
#undef PG8_LDA
#undef PG8_LDB
#undef PG8_MMA
#undef PG8_WAIT_V
#undef PG8_WAIT_L
#undef PG8_BAR
#undef PG8_SCHED
}
}
#define XB_TMO      128
#define XB_XCNT(j)  (256  + 64 * (j))
#define XB_XSUB(j)  (1280 + 64 * (j))
#define XB_XGEN(j)  (2304 + 64 * (j))
#define XB_TOP      3328
#define XB_TOPGEN   3392
#define XCD_BAR_WORDS 3456
#define XB_SPIN_CAP (1u << 18)

__device__ __forceinline__ unsigned xb_ld(unsigned* p)              { return __hip_atomic_load(p, __ATOMIC_RELAXED, __HIP_MEMORY_SCOPE_AGENT); }
__device__ __forceinline__ unsigned xb_add(unsigned* p, unsigned v) { return __hip_atomic_fetch_add(p, v, __ATOMIC_RELAXED, __HIP_MEMORY_SCOPE_AGENT); }
__device__ __forceinline__ unsigned xb_xcc_id() { return (unsigned)__builtin_amdgcn_s_getreg((3 << 11) | 20) & 0xFu; }
#define XB_SPIN(cond, bar) do { unsigned _sp = 0; while (cond) { __builtin_amdgcn_s_sleep(1); \
    if ((++_sp & 255u) == 0u) { if (xb_ld(&(bar)[XB_TMO])) break; if (_sp > XB_SPIN_CAP) { atomicAdd(&(bar)[XB_TMO], 1u); break; } } } } while (0)

struct XcdBarrier {
    unsigned* bar; unsigned x;
    volatile LAS unsigned* st;
};

__device__ __forceinline__ XcdBarrier xcd_barrier_post(unsigned* bar, volatile LAS unsigned* st) {
    XcdBarrier b; b.bar = bar; b.x = xb_xcc_id(); b.st = st;
    if (threadIdx.x == 0) (void)xb_add(&bar[XB_XCNT(b.x)], 1u);
    return b;
}
__device__ __forceinline__ void xcd_barrier_complete(unsigned* bar, unsigned x, unsigned& nloc, unsigned& nx) {
    const unsigned G = gridDim.x * gridDim.y * gridDim.z;
    unsigned sum, cnt, mine, sp = 0u;
    for (;;) {
        sum = 0u; cnt = 0u; mine = 0u;
#pragma unroll
        for (unsigned j = 0; j < 16; ++j) { const unsigned c = xb_ld(&bar[XB_XCNT(j)]); sum += c; cnt += (c > 0u) ? 1u : 0u; mine = (j == x) ? c : mine; }
        if (sum == G) break;
        __builtin_amdgcn_s_sleep(1);
        if ((++sp & 255u) == 0u) { if (xb_ld(&bar[XB_TMO])) break; if (sp > XB_SPIN_CAP) { atomicAdd(&bar[XB_TMO], 1u); break; } }
    }
    nloc = mine > 0u ? mine : 1u; nx = cnt > 0u ? cnt : 1u;
}

__device__ __forceinline__ void xcd_barrier(const XcdBarrier& b) {
    asm volatile("s_waitcnt vmcnt(0)" ::: "memory");
    __syncthreads();
    if (threadIdx.x == 0) {
        unsigned* bar = b.bar;
        __builtin_amdgcn_s_waitcnt(0);
        unsigned nloc = b.st[0], nx = b.st[1];
        if (nloc == 0u) { xcd_barrier_complete(bar, b.x, nloc, nx); b.st[0] = nloc; b.st[1] = nx; }
        const unsigned old = xb_add(&bar[XB_XSUB(b.x)], 1u);
        const unsigned gen = old / nloc;
        if (old + 1u == (gen + 1u) * nloc) {
            __builtin_amdgcn_fence(__ATOMIC_RELEASE, "agent");
            asm volatile("s_waitcnt vmcnt(0)" ::: "memory");
            const unsigned og = xb_add(&bar[XB_TOP], 1u);
            const unsigned tg = og / nx;
            if (og + 1u == (tg + 1u) * nx) xb_add(&bar[XB_TOPGEN], 1u);
            else XB_SPIN(xb_ld(&bar[XB_TOPGEN]) == tg, bar);
            __builtin_amdgcn_fence(__ATOMIC_ACQUIRE, "agent");
            xb_add(&bar[XB_XGEN(b.x)], 1u);
            asm volatile("s_waitcnt vmcnt(0)" ::: "memory");
        } else {
            XB_SPIN(xb_ld(&bar[XB_XGEN(b.x)]) == gen, bar);
            __builtin_amdgcn_fence(__ATOMIC_ACQUIRE, "agent");
            asm volatile("s_waitcnt vmcnt(0)" ::: "memory");
        }
    }
    __syncthreads();
}

typedef float f32x16 __attribute__((ext_vector_type(16)));
typedef unsigned v2u __attribute__((ext_vector_type(2)));
typedef short s16x4 __attribute__((ext_vector_type(4)));
typedef __bf16 bf16x2_t __attribute__((ext_vector_type(2)));
typedef float f32x2_t __attribute__((ext_vector_type(2)));
#define DI __device__ __forceinline__
#define MFMA32(a, b, c) __builtin_amdgcn_mfma_f32_32x32x16_bf16((a), (b), (c), 0, 0, 0)
DI unsigned pk2(float lo, float hi) { f32x2_t v = {lo, hi}; bf16x2_t b = __builtin_convertvector(v, bf16x2_t); return __builtin_bit_cast(unsigned, b); }
DI float bflo(unsigned u) { return __uint_as_float(u << 16); }
DI float bfhi(unsigned u) { return __uint_as_float(u & 0xffff0000u); }
DI int crow(int r, int hi) { return (r & 3) + 8 * (r >> 2) + 4 * hi; }
DI float wave_sum(float v) {
#pragma unroll
    for (int o = 1; o < 64; o <<= 1) v += __shfl_xor(v, o);
    return v;
}
DI float sigm(float x) { return __builtin_amdgcn_rcpf(1.f + __expf(-x)); }

constexpr int M = 16384, DM = 1024, MH = 8192, SEQ = 4096, N1 = 9472, DFF = 4096;
constexpr float RMS_EPS = 1e-6f;
constexpr size_t MiB = 1u << 20;
constexpr size_t WS_CTL = 0, CTL_BYTES = 16384;
constexpr size_t WS_WG = 1 * MiB, WS_WSSD = 5 * MiB, WS_WSB = 9 * MiB, WS_WOUT = 11 * MiB, WS_WFF1 = 13 * MiB, WS_WFF2 = 21 * MiB, WS_WPG = 29 * MiB, WS_WPLE = 31 * MiB;
constexpr size_t WS_CD = 31 * MiB + 512 * 1024;
constexpr size_t WS_DT = 32 * MiB, WS_XN = 34 * MiB, WS_YS = 66 * MiB, WS_YSB = 130 * MiB, WS_XBC = 162 * MiB, WS_W1 = 226 * MiB;
constexpr size_t WS_T2 = 162 * MiB, WS_MG = 66 * MiB, WS_MO = 98 * MiB, WS_N2 = 34 * MiB, WS_HID = 128 * MiB, WS_FO = 34 * MiB, WS_H2B = 98 * MiB, WS_PB = 130 * MiB, WS_PL = 162 * MiB;
constexpr size_t DO_K = 0, DO_V = 16 * MiB, DO_ST = 32 * MiB;
constexpr int LDS_TOTAL = 147456, MISC_OFF = LDS_TOTAL - 128;

struct Args { const float* in[23]; float* out; unsigned char* ws; };

using pg8::Unit;
struct Epi1 {
    static constexpr bool PERM = true, AFTER_DRAIN = false;
    bf16 *Z, *XBC, *Q, *Kh, *Vh; float* DT; const float* dt_bias; int row_off;
    DI void operator()(const f32x4 (&acc)[2][2][4][2], const Unit& u, int wr, int wc, int fr, int fq) const {
        const int pn = u.pn; const int rl0 = u.pm * 256 + wr * 64 + fr;
        if (pn < 36) {
            bf16* base; int ldc, colt, radd;
            if (pn < 8) { base = Z; ldc = 2048; colt = pn * 256; radd = row_off; }
            else if (pn < 24) { base = XBC; ldc = 4096; colt = (pn - 8) * 256; radd = 0; }
            else if (pn < 28) { base = Q; ldc = 1024; colt = (pn - 24) * 256; radd = row_off; }
            else if (pn < 32) { base = Kh; ldc = 1024; colt = (pn - 28) * 256; radd = 0; }
            else { base = Vh; ldc = 1024; colt = (pn - 32) * 256; radd = 0; }
            const int col0 = colt + wc * 32 + 8 * fq;
#pragma unroll
            for (int ai = 0; ai < 2; ++ai)
#pragma unroll
                for (int m = 0; m < 4; ++m) { bf16* rowp = base + (size_t)(radd + rl0 + ai * 128 + m * 16) * ldc + col0;
#pragma unroll
                    for (int bj = 0; bj < 2; ++bj) { const f32x4 v0 = acc[ai][bj][m][0], v1 = acc[ai][bj][m][1];
                        v4u w; w.x = pk2(v0[0], v0[1]); w.y = pk2(v0[2], v0[3]); w.z = pk2(v1[0], v1[1]); w.w = pk2(v1[2], v1[3]);
                        *(v4u*)(rowp + bj * 128) = w; } }
        } else if (wc == 0) {
            const int c0 = 8 * fq;
#pragma unroll
            for (int ai = 0; ai < 2; ++ai)
#pragma unroll
                for (int m = 0; m < 4; ++m) { float* rowp = DT + (size_t)(row_off + rl0 + ai * 128 + m * 16) * 32 + c0;
#pragma unroll
                    for (int n = 0; n < 2; ++n) *(f32x4*)(rowp + 4 * n) = acc[ai][0][m][n]; }
        }
    }
};
template <int MODE> struct EpiF {
    static constexpr bool PERM = false, AFTER_DRAIN = false;
    float* O; const float* bias; const float* P; const float* Q2; bf16* OB;
    DI void operator()(const f32x4 (&acc)[2][2][4][2], const Unit& u, int wr, int wc, int fr, int fq) const {
        const int row0 = u.pm * 256 + wr * 64 + fr, col0 = u.pn * 256 + wc * 32 + 4 * fq;
#pragma unroll
        for (int ai = 0; ai < 2; ++ai)
#pragma unroll
            for (int m = 0; m < 4; ++m) { const size_t ro = (size_t)(row0 + ai * 128 + m * 16) * 1024;
#pragma unroll
                for (int bj = 0; bj < 2; ++bj)
#pragma unroll
                    for (int n = 0; n < 2; ++n) { const int c = col0 + bj * 128 + n * 16; const f32x4 v = acc[ai][bj][m][n];
                        if (MODE == 0) { *(f32x4*)(O + ro + c) = v; }
                        else { f32x4 g; const f32x4 bv = bias ? *(const f32x4*)(bias + c) : (f32x4){0.f, 0.f, 0.f, 0.f};
#pragma unroll
                            for (int j = 0; j < 4; ++j) g[j] = sigm(v[j] + bv[j]);
                            if (MODE == 1) { const f32x4 o = *(const f32x4*)(O + ro + c); *(f32x4*)(O + ro + c) = g * o; }
                            else { const f32x4 p = *(const f32x4*)(P + ro + c), q = *(const f32x4*)(Q2 + ro + c); const f32x4 r = p + g * q;
                                v2u w; w.x = pk2(r[0], r[1]); w.y = pk2(r[2], r[3]); *(v2u*)(OB + ro + c) = w; } } } }
    }
};
struct EpiRelu2 {
    static constexpr bool PERM = true, AFTER_DRAIN = false;
    bf16* O;
    DI void operator()(const f32x4 (&acc)[2][2][4][2], const Unit& u, int wr, int wc, int fr, int fq) const {
        const int row0 = u.pm * 256 + wr * 64 + fr, col0 = u.pn * 256 + wc * 32 + 8 * fq;
#pragma unroll
        for (int ai = 0; ai < 2; ++ai)
#pragma unroll
            for (int m = 0; m < 4; ++m) { bf16* rowp = O + (size_t)(row0 + ai * 128 + m * 16) * DFF + col0;
#pragma unroll
                for (int bj = 0; bj < 2; ++bj) { f32x4 v0 = acc[ai][bj][m][0], v1 = acc[ai][bj][m][1];
#pragma unroll
                    for (int j = 0; j < 4; ++j) { const float a = fmaxf(v0[j], 0.f), b = fmaxf(v1[j], 0.f); v0[j] = a * a; v1[j] = b * b; }
                    v4u w; w.x = pk2(v0[0], v0[1]); w.y = pk2(v0[2], v0[3]); w.z = pk2(v1[0], v1[1]); w.w = pk2(v1[2], v1[3]);
                    *(v4u*)(rowp + bj * 128) = w; } }
    }
};

struct Frame {
    LAS unsigned char* lds; int tid, lane, wave, G, bid;
    const __attribute__((address_space(4))) Args* A; float* out; unsigned char* ws;
};
#define LDS_WAIT() asm volatile("s_waitcnt lgkmcnt(0)" ::: "memory")

DI void tr_item(const float* W, int N, int K, bf16* WT, int k0, int n0, int drow, LAS float* scr, int lane) {
#pragma unroll 8
    for (int i = 0; i < 32; ++i) { const int kk = 2 * i + (lane >> 5); scr[kk * 33 + (lane & 31)] = W[(size_t)(k0 + kk) * N + n0 + (lane & 31)]; }
    LDS_WAIT();
    const int c = lane & 7;
#pragma unroll
    for (int j = 0; j < 4; ++j) { const int n = (lane >> 3) + 8 * j; const LAS float* s = scr + (8 * c) * 33 + n;
        v4u o; o.x = pk2(s[0 * 33], s[1 * 33]); o.y = pk2(s[2 * 33], s[3 * 33]); o.z = pk2(s[4 * 33], s[5 * 33]); o.w = pk2(s[6 * 33], s[7 * 33]);
        *(v4u*)(WT + (size_t)(drow + n) * K + k0 + 8 * c) = o; }
    LDS_WAIT();
}
DI void rms_row_bf16(const float* xrow, const float* w, bf16* orow, int lane) {
    f32x4 v[4]; float s = 0.f;
#pragma unroll
    for (int j = 0; j < 4; ++j) { v[j] = ((const f32x4*)xrow)[lane + 64 * j]; s += (v[j].x * v[j].x + v[j].y * v[j].y) + (v[j].z * v[j].z + v[j].w * v[j].w); }
    const float r = rsqrtf(wave_sum(s) * (1.f / 1024.f) + RMS_EPS);
#pragma unroll
    for (int j = 0; j < 4; ++j) { const f32x4 wv = ((const f32x4*)w)[lane + 64 * j]; v2u o; o.x = pk2(v[j].x * r * wv.x, v[j].y * r * wv.y); o.y = pk2(v[j].z * r * wv.z, v[j].w * r * wv.w);
        ((v2u*)orow)[lane + 64 * j] = o; }
}
DI void p0_prologue(Frame& F) {
    LAS float* scr = (LAS float*)(F.lds + F.wave * 16384);
    const int gw = F.bid * 8 + F.wave, NGW = F.G * 8;
    unsigned char* ws = F.ws;
    constexpr int I_IN = 16 * 289, I_G = 16 * 64, I_SSD = 32 * 32, I_SB = 16 * 32, I_OUT = 16 * 32, I_F1 = 16 * 128, I_F2 = 64 * 32, I_PLE = 4 * 32, I_PG = 16 * 32;
    constexpr int NITEMS = I_IN + I_G + I_SSD + I_SB + I_OUT + I_F1 + I_F2 + I_PLE + I_PG;
    for (int it = gw; it < NITEMS; it += NGW) {
        int r = it;
        if (r < I_IN) { const int kb = r / 289, nb = r % 289, n0 = 32 * nb; const int drow = n0 < 6144 ? n0 : (n0 < 6176 ? 9216 + (n0 - 6144) : n0 - 32);
            tr_item(F.A->in[3], 9248, 1024, (bf16*)(ws + WS_W1), 64 * kb, n0, drow, scr, F.lane); continue; } r -= I_IN;
#define TRM(CNT, IDX, NN, KK, OFF) if (r < CNT) { const int nblk = (NN) / 32, kb = r / nblk, nb = r % nblk; tr_item(F.A->in[IDX], NN, KK, (bf16*)(ws + OFF), 64 * kb, 32 * nb, 32 * nb, scr, F.lane); continue; } r -= CNT;
        TRM(I_G, 12, 2048, 1024, WS_WG)
        TRM(I_SSD, 10, 1024, 2048, WS_WSSD)
        TRM(I_SB, 11, 1024, 1024, WS_WSB)
        TRM(I_OUT, 14, 1024, 1024, WS_WOUT)
        TRM(I_F1, 17, 4096, 1024, WS_WFF1)
        TRM(I_F2, 18, 1024, 4096, WS_WFF2)
        TRM(I_PLE, 20, 1024, 256, WS_WPLE)
        TRM(I_PG, 21, 1024, 1024, WS_WPG)
#undef TRM
    }
    { v4u* z = (v4u*)((bf16*)(ws + WS_W1) + (size_t)9248 * 1024); const int n16 = 224 * 1024 * 2 / 16;
      for (int i = F.bid * 512 + F.tid; i < n16; i += F.G * 512) z[i] = (v4u){0u, 0u, 0u, 0u}; }
    for (int m = gw; m < M; m += NGW) rms_row_bf16(F.A->in[0] + (size_t)m * DM, F.A->in[2], (bf16*)(ws + WS_XN) + (size_t)m * DM, F.lane);
}

DI void attn_wave_unit(bf16* QO, const bf16* Kh, const bf16* Vh, int hb, int bl, int h, int qb, LAS unsigned short* vts, int lane, bool dry = false) {
    const int r32 = lane & 31, hi = lane >> 5;
    const size_t rowQ = (size_t)(hb * 2 + bl) * SEQ, rowK = (size_t)bl * SEQ;
    bf16x8 qf[4];
    { const bf16* qp = QO + (rowQ + qb * 32 + r32) * 1024 + h * 64 + 8 * hi;
#pragma unroll
      for (int d0 = 0; d0 < 4; ++d0) qf[d0] = *(const bf16x8*)(qp + 16 * d0); }
    f32x16 o0, o1;
#pragma unroll
    for (int i = 0; i < 16; ++i) { o0[i] = 0.f; o1[i] = 0.f; }
    float R = 0.f;
    const int qabs = qb * 32 + r32;
    const float C2 = 0.125f * 1.4426950408889634f;
    bf16x8 kfn[4], vrn[4];
    { const bf16* kp = Kh + (rowK + qb * 32 + r32) * 1024 + h * 64 + 8 * hi; const bf16* vp = Vh + (rowK + qb * 32 + (lane & 31)) * 1024 + h * 64 + 32 * (lane >> 5);
#pragma unroll
      for (int d0 = 0; d0 < 4; ++d0) { kfn[d0] = *(const bf16x8*)(kp + 16 * d0); vrn[d0] = *(const bf16x8*)(vp + 8 * d0); } }
    for (int kt = qb; kt >= 0; --kt) {
        bf16x8 kf[4], vr[4];
#pragma unroll
        for (int d0 = 0; d0 < 4; ++d0) { kf[d0] = kfn[d0]; vr[d0] = vrn[d0]; }
        if (kt > 0) { const bf16* kp = Kh + (rowK + (kt - 1) * 32 + r32) * 1024 + h * 64 + 8 * hi; const bf16* vp = Vh + (rowK + (kt - 1) * 32 + (lane & 31)) * 1024 + h * 64 + 32 * (lane >> 5);
#pragma unroll
          for (int d0 = 0; d0 < 4; ++d0) { kfn[d0] = *(const bf16x8*)(kp + 16 * d0); vrn[d0] = *(const bf16x8*)(vp + 8 * d0); } }
        { const int key = lane & 31, dq = lane >> 5;
#pragma unroll
          for (int c = 0; c < 4; ++c) {
#pragma unroll
              for (int j = 0; j < 8; ++j) vts[(32 * dq + 8 * c + j) * 36 + key] = (unsigned short)vr[c][j]; } }
        f32x16 s;
#pragma unroll
        for (int i = 0; i < 16; ++i) s[i] = 0.f;
#pragma unroll
        for (int d0 = 0; d0 < 4; ++d0) s = MFMA32(kf[d0], qf[d0], s);
        float lk[16], ls[16];
#pragma unroll
        for (int i = 0; i < 16; ++i) {
            const float z2 = s[i] * C2; const float e = __builtin_amdgcn_exp2f(-fabsf(z2)); const float sp = fmaxf(z2, 0.f) + __log2f(1.f + e);
            lk[i] = -sp; ls[i] = z2 - sp;
        }
        if (kt == qb) {
#pragma unroll
            for (int i = 0; i < 16; ++i) { const bool valid = (kt * 32 + crow(i, hi)) < qabs; lk[i] = valid ? lk[i] : 0.f; ls[i] = valid ? ls[i] : -INFINITY; }
        }
        float gs[4], og[4], T[4];
#pragma unroll
        for (int a = 0; a < 4; ++a) { gs[a] = (lk[4 * a] + lk[4 * a + 1]) + (lk[4 * a + 2] + lk[4 * a + 3]); og[a] = __shfl_xor(gs[a], 32); T[a] = gs[a] + og[a]; }
        float ST[4]; ST[3] = 0.f; ST[2] = T[3]; ST[1] = T[3] + T[2]; ST[0] = ST[1] + T[1];
        float p[16];
#pragma unroll
        for (int a = 0; a < 4; ++a) {
            const float l3 = R + ST[a] + (hi == 0 ? og[a] : 0.f);
            const float l2 = l3 + lk[4 * a + 3], l1 = l2 + lk[4 * a + 2], l0 = l1 + lk[4 * a + 1];
            p[4 * a + 3] = __builtin_amdgcn_exp2f(ls[4 * a + 3] + l3); p[4 * a + 2] = __builtin_amdgcn_exp2f(ls[4 * a + 2] + l2);
            p[4 * a + 1] = __builtin_amdgcn_exp2f(ls[4 * a + 1] + l1); p[4 * a] = __builtin_amdgcn_exp2f(ls[4 * a] + l0);
        }
        R += (T[0] + T[1]) + (T[2] + T[3]);
        LDS_WAIT();
#pragma unroll
        for (int ks = 0; ks < 2; ++ks) {
            v4u pw; pw.x = pk2(p[8 * ks], p[8 * ks + 1]); pw.y = pk2(p[8 * ks + 2], p[8 * ks + 3]); pw.z = pk2(p[8 * ks + 4], p[8 * ks + 5]); pw.w = pk2(p[8 * ks + 6], p[8 * ks + 7]);
            const bf16x8 pb = __builtin_bit_cast(bf16x8, pw);
            { const LAS unsigned short* vr = vts + r32 * 36 + 16 * ks + 4 * hi; const s16x4 lo = *(const LAS s16x4*)vr, hh = *(const LAS s16x4*)(vr + 8);
              const bf16x8 va = __builtin_shufflevector(lo, hh, 0, 1, 2, 3, 4, 5, 6, 7); o0 = MFMA32(va, pb, o0); }
            { const LAS unsigned short* vr = vts + (32 + r32) * 36 + 16 * ks + 4 * hi; const s16x4 lo = *(const LAS s16x4*)vr, hh = *(const LAS s16x4*)(vr + 8);
              const bf16x8 va = __builtin_shufflevector(lo, hh, 0, 1, 2, 3, 4, 5, 6, 7); o1 = MFMA32(va, pb, o1); }
        }
        LDS_WAIT();
        if (__all(R < -160.f)) break;
    }
    bf16* op = QO + (rowQ + qb * 32 + r32) * 1024 + h * 64;
    if (dry) return;
#pragma unroll
    for (int a = 0; a < 4; ++a) {
        v2u w0; w0.x = pk2(o0[4 * a], o0[4 * a + 1]); w0.y = pk2(o0[4 * a + 2], o0[4 * a + 3]); *(v2u*)(op + 8 * a + 4 * hi) = w0;
        v2u w1; w1.x = pk2(o1[4 * a], o1[4 * a + 1]); w1.y = pk2(o1[4 * a + 2], o1[4 * a + 3]); *(v2u*)(op + 32 + 8 * a + 4 * hi) = w1;
    }
}

constexpr int LDP = 136;
template <int MODE> DI void conv_run(const bf16* rowbase, int c, int ch0, int tl0, const float* conv_w, const float* conv_b, LAS bf16* dst, int lc, const LAS float* scale) {
    float w[4][4], bias[4];
#pragma unroll
    for (int k = 0; k < 4; ++k) { const f32x4 a = *(const f32x4*)(conv_w + k * 4096 + ch0); w[k][0] = a.x; w[k][1] = a.y; w[k][2] = a.z; w[k][3] = a.w; }
    { const f32x4 a = *(const f32x4*)(conv_b + ch0); bias[0] = a.x; bias[1] = a.y; bias[2] = a.z; bias[3] = a.w; }
    float win[3][4];
#pragma unroll
    for (int k = 0; k < 3; ++k) { const int t = tl0 - 3 + k; v2u u = (v2u){0u, 0u};
        if (c * 128 + t >= 0) u = *(const v2u*)(rowbase + (long)t * 4096 + ch0);
        win[k][0] = bflo(u.x); win[k][1] = bfhi(u.x); win[k][2] = bflo(u.y); win[k][3] = bfhi(u.y); }
#pragma unroll 2
    for (int sb = 0; sb < 4; ++sb) {
        unsigned pk[4][4]; float hold[4];
#pragma unroll
        for (int tt = 0; tt < 8; ++tt) {
            const int t = tl0 + 8 * sb + tt; const v2u u = *(const v2u*)(rowbase + (long)t * 4096 + ch0);
            float cur[4]; cur[0] = bflo(u.x); cur[1] = bfhi(u.x); cur[2] = bflo(u.y); cur[3] = bfhi(u.y);
            float y[4]; float sc = 1.f; if (MODE == 0) sc = scale[t];
#pragma unroll
            for (int j = 0; j < 4; ++j) { float v = bias[j] + w[0][j] * win[0][j] + w[1][j] * win[1][j] + w[2][j] * win[2][j] + w[3][j] * cur[j];
                v = v * __builtin_amdgcn_rcpf(1.f + __expf(-v)); y[j] = v * sc; }
            if (MODE == 2) { v2u o; o.x = pk2(y[0], y[1]); o.y = pk2(y[2], y[3]); *(LAS v2u*)(dst + t * LDP + lc) = o; }
            else {
#pragma unroll
                for (int j = 0; j < 4; ++j) { if ((tt & 1) == 0) hold[j] = y[j]; else pk[j][tt >> 1] = pk2(hold[j], y[j]); }
            }
#pragma unroll
            for (int j = 0; j < 4; ++j) { win[0][j] = win[1][j]; win[1][j] = win[2][j]; win[2][j] = cur[j]; }
        }
        if (MODE != 2) {
#pragma unroll
            for (int j = 0; j < 4; ++j) { v4u o; o.x = pk[j][0]; o.y = pk[j][1]; o.z = pk[j][2]; o.w = pk[j][3]; *(LAS v4u*)(dst + (lc + j) * LDP + tl0 + 8 * sb) = o; }
        }
    }
}
template <bool WANT_DTE> DI void ssd_acs(Frame& F, const float* DT, int rowfull, int g, LAS float* ACS, LAS float* AUX, float* cd_out) {
    if (F.wave < 4) {
        const int hh = g * 4 + F.wave, l = F.lane; const float a = -__expf(F.A->in[7][hh]);
        const float dtb = F.A->in[6][hh];
        const float x0 = DT[(size_t)(rowfull + 2 * l) * 32 + hh] + dtb, x1 = DT[(size_t)(rowfull + 2 * l + 1) * 32 + hh] + dtb;
        const float dt0 = fmaxf(x0, 0.f) + log1pf(__expf(-fabsf(x0))), dt1 = fmaxf(x1, 0.f) + log1pf(__expf(-fabsf(x1)));
        const float v0 = dt0 * a, v1 = dt1 * a, s = v0 + v1; float incl = s;
#pragma unroll
        for (int o = 1; o < 64; o <<= 1) { const float t = __shfl_up(incl, o); if (l >= o) incl += t; }
        const float excl = incl - s, acs0 = excl + v0, acs1 = incl, tot = __shfl(incl, 63);
        ACS[F.wave * 128 + 2 * l] = acs0; ACS[F.wave * 128 + 2 * l + 1] = acs1;
        if (WANT_DTE) { AUX[F.wave * 128 + 2 * l] = dt0 * __expf(tot - acs0); AUX[F.wave * 128 + 2 * l + 1] = dt1 * __expf(tot - acs1); if (l == 63) cd_out[hh] = __expf(tot); }
        else { AUX[F.wave * 128 + 2 * l] = dt0; AUX[F.wave * 128 + 2 * l + 1] = dt1; }
    }
}
DI void ssd_states_unit(Frame& F, int hb, int bl, int c, int g) {
    LAS bf16* XST = (LAS bf16*)F.lds; LAS bf16* BT = (LAS bf16*)(F.lds + 69632); LAS float* ACS = (LAS float*)(F.lds + 104448); LAS float* DTE = (LAS float*)(F.lds + 106496);
    const int rowfull = hb * MH + bl * SEQ + c * 128;
    const bf16* rowbase = (const bf16*)(F.ws + WS_XBC) + (size_t)(bl * SEQ + c * 128) * 4096;
    float* CD = (float*)(F.ws + WS_CD) + (bl * 32 + c) * 32;
    ssd_acs<true>(F, (const float*)(F.ws + WS_DT), rowfull, g, ACS, DTE, CD);
    __syncthreads();
    if (F.tid < 384) { const int cgi = F.tid % 96, tr = F.tid / 96;
        if (cgi < 64) conv_run<0>(rowbase, c, g * 256 + 4 * cgi, 32 * tr, F.A->in[4], F.A->in[5], XST, 4 * cgi, DTE + (cgi >> 4) * 128);
        else conv_run<1>(rowbase, c, 2048 + g * 128 + 4 * (cgi - 64), 32 * tr, F.A->in[4], F.A->in[5], BT, 4 * (cgi - 64), nullptr); }
    __syncthreads();
    const int r32 = F.lane & 31, hi = F.lane >> 5, hl = F.wave >> 1, pt = F.wave & 1;
    f32x16 acc[4];
#pragma unroll
    for (int nt = 0; nt < 4; ++nt)
#pragma unroll
        for (int i = 0; i < 16; ++i) acc[nt][i] = 0.f;
#pragma unroll
    for (int ks = 0; ks < 8; ++ks) { const bf16x8 xf = *(const LAS bf16x8*)(XST + (hl * 64 + pt * 32 + r32) * LDP + 16 * ks + 8 * hi);
#pragma unroll
        for (int nt = 0; nt < 4; ++nt) { const bf16x8 bfr = *(const LAS bf16x8*)(BT + (32 * nt + r32) * LDP + 16 * ks + 8 * hi); acc[nt] = MFMA32(bfr, xf, acc[nt]); } }
    bf16* st = (bf16*)((unsigned char*)F.out + DO_ST) + ((size_t)((bl * 32 + c) * 32 + g * 4 + hl) * 64 + 32 * pt + r32) * 128;
#pragma unroll
    for (int nt = 0; nt < 4; ++nt)
#pragma unroll
        for (int a = 0; a < 4; ++a) { v2u w; w.x = pk2(acc[nt][4 * a], acc[nt][4 * a + 1]); w.y = pk2(acc[nt][4 * a + 2], acc[nt][4 * a + 3]); *(v2u*)(st + 32 * nt + 8 * a + 4 * hi) = w; }
    __syncthreads();
}
DI void ssd_scan(Frame& F, bool dry = false) {
    bf16* ST = (bf16*)((unsigned char*)F.out + DO_ST); const float* CD = (const float*)(F.ws + WS_CD);
    for (int e = F.bid * 512 + F.tid; e < 262144; e += F.G * 512) {
        const int n2 = e & 63, p = (e >> 6) & 63, h = (e >> 12) & 31, bl = e >> 17;
        unsigned* base = (unsigned*)(ST + ((size_t)(bl * 1024 + h) * 64 + p) * 128 + 2 * n2);
        unsigned v[32];
#pragma unroll
        for (int c = 0; c < 32; ++c) v[c] = base[(size_t)c * 131072];
        float p0 = 0.f, p1 = 0.f;
#pragma unroll
        for (int c = 0; c < 32; ++c) { const float dec = CD[(bl * 32 + c) * 32 + h]; if (!dry) base[(size_t)c * 131072] = pk2(p0, p1); p0 = p0 * dec + bflo(v[c]); p1 = p1 * dec + bfhi(v[c]); }
    }
}
DI void ssd_final_unit(Frame& F, int hb, int bl, int c, int g, bool dry = false) {
    LAS bf16* XST = (LAS bf16*)F.lds; LAS bf16* BM = (LAS bf16*)(F.lds + 69632); LAS bf16* CM = (LAS bf16*)(F.lds + 104448);
    LAS float* ACS = (LAS float*)(F.lds + 139264); LAS float* DTS = (LAS float*)(F.lds + 141312); LAS float* NRM = (LAS float*)(F.lds + 143360);
    const int rowfull = hb * MH + bl * SEQ + c * 128;
    const bf16* rowbase = (const bf16*)(F.ws + WS_XBC) + (size_t)(bl * SEQ + c * 128) * 4096;
    ssd_acs<false>(F, (const float*)(F.ws + WS_DT), rowfull, g, ACS, DTS, nullptr);
    { const int cgi = F.tid & 127, tr = F.tid >> 7;
      if (cgi < 64) conv_run<1>(rowbase, c, g * 256 + 4 * cgi, 32 * tr, F.A->in[4], F.A->in[5], XST, 4 * cgi, nullptr);
      else if (cgi < 96) conv_run<2>(rowbase, c, 2048 + g * 128 + 4 * (cgi - 64), 32 * tr, F.A->in[4], F.A->in[5], BM, 4 * (cgi - 64), nullptr);
      else conv_run<2>(rowbase, c, 3072 + g * 128 + 4 * (cgi - 96), 32 * tr, F.A->in[4], F.A->in[5], CM, 4 * (cgi - 96), nullptr); }
    __syncthreads();
    const int r32 = F.lane & 31, hi = F.lane >> 5, lt = F.wave >> 1, hp = F.wave & 1;
    const int l = 32 * lt + r32;
    bf16x8 cf[8];
#pragma unroll
    for (int ks = 0; ks < 8; ++ks) cf[ks] = *(const LAS bf16x8*)(CM + l * LDP + 16 * ks + 8 * hi);
    f32x16 acc[2][2];
#pragma unroll
    for (int hd = 0; hd < 2; ++hd)
#pragma unroll
        for (int pt = 0; pt < 2; ++pt)
#pragma unroll
            for (int i = 0; i < 16; ++i) acc[hd][pt][i] = 0.f;
    const bf16* PV = (const bf16*)((const unsigned char*)F.out + DO_ST);
#pragma unroll
    for (int hd = 0; hd < 2; ++hd) { const int head = g * 4 + 2 * hp + hd;
#pragma unroll
        for (int pt = 0; pt < 2; ++pt) { const bf16* pp = PV + ((size_t)((bl * 32 + c) * 32 + head) * 64 + 32 * pt + r32) * 128 + 8 * hi;
#pragma unroll
            for (int ks = 0; ks < 8; ++ks) { const bf16x8 pf = *(const bf16x8*)(pp + 16 * ks); acc[hd][pt] = MFMA32(pf, cf[ks], acc[hd][pt]); } }
        const float el = __expf(ACS[(2 * hp + hd) * 128 + l]);
#pragma unroll
        for (int pt = 0; pt < 2; ++pt)
#pragma unroll
            for (int i = 0; i < 16; ++i) acc[hd][pt][i] *= el; }
    for (int st = 0; st <= lt; ++st) {
        f32x16 cb;
#pragma unroll
        for (int i = 0; i < 16; ++i) cb[i] = 0.f;
#pragma unroll
        for (int ks = 0; ks < 8; ++ks) { const bf16x8 bfr = *(const LAS bf16x8*)(BM + (32 * st + r32) * LDP + 16 * ks + 8 * hi); cb = MFMA32(bfr, cf[ks], cb); }
#pragma unroll
        for (int hd = 0; hd < 2; ++hd) { const int hl = 2 * hp + hd; const float al = ACS[hl * 128 + l]; const float dsk = F.A->in[8][g * 4 + hl];
            float mv[16];
#pragma unroll
            for (int a = 0; a < 4; ++a) { const int s0 = 32 * st + 8 * a + 4 * hi; const f32x4 as = *(const LAS f32x4*)(ACS + hl * 128 + s0), ds = *(const LAS f32x4*)(DTS + hl * 128 + s0);
#pragma unroll
                for (int j = 0; j < 4; ++j) { const int s = s0 + j; float m = cb[4 * a + j] * __expf(fminf(al - as[j], 0.f)) * ds[j]; m = (s <= l) ? m : 0.f; m += (s == l) ? dsk : 0.f; mv[4 * a + j] = m; } }
#pragma unroll
            for (int ks2 = 0; ks2 < 2; ++ks2) { v4u mw; mw.x = pk2(mv[8 * ks2], mv[8 * ks2 + 1]); mw.y = pk2(mv[8 * ks2 + 2], mv[8 * ks2 + 3]); mw.z = pk2(mv[8 * ks2 + 4], mv[8 * ks2 + 5]); mw.w = pk2(mv[8 * ks2 + 6], mv[8 * ks2 + 7]);
                const bf16x8 mb = __builtin_bit_cast(bf16x8, mw);
#pragma unroll
                for (int pt = 0; pt < 2; ++pt) { const LAS bf16* xr = XST + (hl * 64 + 32 * pt + r32) * LDP + 32 * st + 16 * ks2 + 4 * hi;
                    const s16x4 lo = *(const LAS s16x4*)xr, hh = *(const LAS s16x4*)(xr + 8); const bf16x8 xa = __builtin_shufflevector(lo, hh, 0, 1, 2, 3, 4, 5, 6, 7);
                    acc[hd][pt] = MFMA32(xa, mb, acc[hd][pt]); } } }
    }
    bf16* yrow = (bf16*)(F.ws + WS_YS) + (size_t)(rowfull + l) * 2048 + g * 256;
    float ss = 0.f;
#pragma unroll
    for (int hd = 0; hd < 2; ++hd)
#pragma unroll
        for (int pt = 0; pt < 2; ++pt)
#pragma unroll
            for (int a = 0; a < 4; ++a) { const v2u zz = *(const v2u*)(yrow + (2 * hp + hd) * 64 + 32 * pt + 8 * a + 4 * hi);
                const float z0 = bflo(zz.x), z1 = bfhi(zz.x), z2 = bflo(zz.y), z3 = bfhi(zz.y);
                float y0 = acc[hd][pt][4 * a] * z0 * sigm(z0), y1 = acc[hd][pt][4 * a + 1] * z1 * sigm(z1), y2 = acc[hd][pt][4 * a + 2] * z2 * sigm(z2), y3 = acc[hd][pt][4 * a + 3] * z3 * sigm(z3);
                acc[hd][pt][4 * a] = y0; acc[hd][pt][4 * a + 1] = y1; acc[hd][pt][4 * a + 2] = y2; acc[hd][pt][4 * a + 3] = y3; ss += (y0 * y0 + y1 * y1) + (y2 * y2 + y3 * y3); }
    ss += __shfl_xor(ss, 32);
    if (hi == 0) NRM[F.wave * 32 + r32] = ss;
    __syncthreads();
    const float tot = NRM[(2 * lt) * 32 + r32] + NRM[(2 * lt + 1) * 32 + r32];
    const float rs = rsqrtf(tot * (1.f / 256.f) + RMS_EPS);
    const float* nw = F.A->in[9] + g * 256;
#pragma unroll
    for (int hd = 0; hd < 2; ++hd)
#pragma unroll
        for (int pt = 0; pt < 2; ++pt)
#pragma unroll
            for (int a = 0; a < 4; ++a) { const int ch = (2 * hp + hd) * 64 + 32 * pt + 8 * a + 4 * hi; const f32x4 wv = *(const f32x4*)(nw + ch);
                v2u o; o.x = pk2(acc[hd][pt][4 * a] * rs * wv.x, acc[hd][pt][4 * a + 1] * rs * wv.y); o.y = pk2(acc[hd][pt][4 * a + 2] * rs * wv.z, acc[hd][pt][4 * a + 3] * rs * wv.w);
                if (!dry) *(v2u*)(yrow + ch) = o; }
    __syncthreads();
}

template <int MODE> DI void norm_rows(Frame& F, const float* src, const float* w1, const float* w2, bf16* ob) {
    const int gw = F.bid * 8 + F.wave, NGW = F.G * 8, lane = F.lane;
    for (int m = gw; m < M; m += NGW) {
        const f32x4* sr = (const f32x4*)(src + (size_t)m * DM); const f32x4* br = (const f32x4*)((MODE == 0 ? F.A->in[0] : F.out) + (size_t)m * DM);
        f32x4 v[4], b[4]; float s = 0.f;
#pragma unroll
        for (int j = 0; j < 4; ++j) { v[j] = sr[lane + 64 * j]; b[j] = br[lane + 64 * j]; s += (v[j].x * v[j].x + v[j].y * v[j].y) + (v[j].z * v[j].z + v[j].w * v[j].w); }
        const float r = rsqrtf(wave_sum(s) * (1.f / 1024.f) + RMS_EPS); float s2 = 0.f;
#pragma unroll
        for (int j = 0; j < 4; ++j) { const f32x4 wv = ((const f32x4*)w1)[lane + 64 * j]; v[j] = b[j] + v[j] * r * wv; ((f32x4*)(F.out + (size_t)m * DM))[lane + 64 * j] = v[j];
            s2 += (v[j].x * v[j].x + v[j].y * v[j].y) + (v[j].z * v[j].z + v[j].w * v[j].w); }
        if (MODE == 0) { const float r2 = rsqrtf(wave_sum(s2) * (1.f / 1024.f) + RMS_EPS);
#pragma unroll
            for (int j = 0; j < 4; ++j) { const f32x4 wv = ((const f32x4*)w2)[lane + 64 * j]; v2u o; o.x = pk2(v[j].x * r2 * wv.x, v[j].y * r2 * wv.y); o.y = pk2(v[j].z * r2 * wv.z, v[j].w * r2 * wv.w);
                ((v2u*)(ob + (size_t)m * DM))[lane + 64 * j] = o; } }
        if (MODE == 1) {
#pragma unroll
            for (int j = 0; j < 4; ++j) { v2u o; o.x = pk2(v[j].x, v[j].y); o.y = pk2(v[j].z, v[j].w); ((v2u*)(ob + (size_t)m * DM))[lane + 64 * j] = o; } }
    }
}

__global__ void __launch_bounds__(512, 2) fwd_megakernel(Args args) {
    extern __shared__ __attribute__((aligned(16))) unsigned char lds_raw[];
    Frame F; F.lds = (LAS unsigned char*)lds_raw; F.tid = threadIdx.x; F.lane = F.tid & 63; F.wave = __builtin_amdgcn_readfirstlane(F.tid >> 6); F.G = gridDim.x; F.bid = blockIdx.x;
    F.A = (const __attribute__((address_space(4))) Args*)__builtin_amdgcn_kernarg_segment_ptr();
    F.out = F.A->out; F.ws = F.A->ws;
    volatile LAS unsigned* MISC = (volatile LAS unsigned*)(F.lds + MISC_OFF);
    if (F.tid < 32) MISC[F.tid] = 0u;
    __syncthreads();
    XcdBarrier bar = xcd_barrier_post((unsigned*)(F.ws + WS_CTL), MISC + 8);
#define LAUNDER() asm volatile("" : "+s"(F.A), "+v"(F.tid), "+v"(F.lane), "+s"(F.wave), "+s"(F.bid))
#define GRID_BAR() do { xcd_barrier(bar); LAUNDER(); } while (0)
    unsigned char* ws = F.ws; unsigned char* ob = (unsigned char*)F.out;
    bf16* XN = (bf16*)(ws + WS_XN); bf16* YS = (bf16*)(ws + WS_YS); bf16* YSB = (bf16*)(ws + WS_YSB);

#ifndef SKIP_P0
    p0_prologue(F);
#endif
#ifdef PROBE_P0
    LAUNDER(); p0_prologue(F);
#endif
    if (F.ws == nullptr) cg::this_grid().sync();
    GRID_BAR();

    for (int hb = 0; hb < 2; ++hb) {
#ifndef SKIP_G1
        {
            pg8::Gemm g{XN + (size_t)hb * MH * DM, (const bf16*)(ws + WS_W1), MH, N1, DM}; pg8::StaticOrder S; S.init(MH, N1, F.G, F.bid);
            Epi1 E{YS, (bf16*)(ws + WS_XBC), YSB, (bf16*)(ob + DO_K), (bf16*)(ob + DO_V), (float*)(ws + WS_DT), F.A->in[6], hb * MH};
            pg8::gemm_phase<Epi1, pg8::StaticOrder, true, true>(F.lds, g, S, E);
        }
#endif

        GRID_BAR();
        {
            LAS unsigned short* vts = (LAS unsigned short*)(F.lds + F.wave * 4608);
#ifdef PROBE_ATT
            for (int u = F.bid * 8 + F.wave; u < 4096; u += F.G * 8) { const int qb = 127 - (u & 127), h = (u >> 7) & 15, bl = u >> 11;
                attn_wave_unit(YSB, (const bf16*)(ob + DO_K), (const bf16*)(ob + DO_V), hb, bl, h, qb, vts, F.lane, F.G != 12345); }
            LAUNDER();
#endif
#ifndef SKIP_ATT
            for (int u = F.bid * 8 + F.wave; u < 4096; u += F.G * 8) { const int qb = 127 - (u & 127), h = (u >> 7) & 15, bl = u >> 11;
                attn_wave_unit(YSB, (const bf16*)(ob + DO_K), (const bf16*)(ob + DO_V), hb, bl, h, qb, vts, F.lane); }
#endif
            __syncthreads();
            LAUNDER();
#ifdef PROBE_P2
            for (int u = F.bid; u < 512; u += F.G) { const int g = u & 7, c = (u >> 3) & 31, bl = u >> 8; ssd_states_unit(F, hb, bl, c, g); }
            LAUNDER();
#endif
#ifndef SKIP_P2
            for (int u = F.bid; u < 512; u += F.G) { const int g = u & 7, c = (u >> 3) & 31, bl = u >> 8; ssd_states_unit(F, hb, bl, c, g); }
#endif
        }
        GRID_BAR();
#ifdef PROBE_SCAN
        ssd_scan(F, F.G != 12345); LAUNDER();
#endif
#ifndef SKIP_SCAN
        ssd_scan(F);
#endif
        GRID_BAR();
#ifdef PROBE_P3
        for (int u = F.bid; u < 512; u += F.G) { const int g = u & 7, c = (u >> 3) & 31, bl = u >> 8; ssd_final_unit(F, hb, bl, c, g, F.G != 12345); }
        LAUNDER();
#endif
#ifndef SKIP_P3
        for (int u = F.bid; u < 512; u += F.G) { const int g = u & 7, c = (u >> 3) & 31, bl = u >> 8; ssd_final_unit(F, hb, bl, c, g); }
#endif
        GRID_BAR();
    }
    float* MRG = (float*)ob; float* T2 = (float*)(ws + WS_T2);
#ifndef SKIP_M1
    {
        pg8::StaticOrder S; S.init(M, DM, F.G, F.bid);
        { pg8::Gemm g{YS, (const bf16*)(ws + WS_WSSD), M, DM, 2048}; EpiF<0> E{MRG, nullptr, nullptr, nullptr, nullptr}; pg8::gemm_phase<EpiF<0>, pg8::StaticOrder, true, true>(F.lds, g, S, E); }
        { pg8::Gemm g{YSB, (const bf16*)(ws + WS_WSB), M, DM, DM}; EpiF<0> E{T2, nullptr, nullptr, nullptr, nullptr}; pg8::gemm_phase<EpiF<0>, pg8::StaticOrder, true, true>(F.lds, g, S, E); }
    }
#endif

    GRID_BAR();
#ifndef SKIP_M2
    {
        pg8::StaticOrder S; S.init(M, DM, F.G, F.bid);
        { pg8::Gemm g{XN, (const bf16*)(ws + WS_WG), M, DM, DM}; EpiF<1> E{MRG, F.A->in[13], nullptr, nullptr, nullptr}; pg8::gemm_phase<EpiF<1>, pg8::StaticOrder, true, true>(F.lds, g, S, E); }
        { pg8::Gemm g{XN, (const bf16*)(ws + WS_WG) + (size_t)1024 * 1024, M, DM, DM}; EpiF<2> E{nullptr, F.A->in[13] + 1024, MRG, T2, (bf16*)(ws + WS_MG)}; pg8::gemm_phase<EpiF<2>, pg8::StaticOrder, true, true>(F.lds, g, S, E); }
    }
#endif

    GRID_BAR();
#ifndef SKIP_WOUT
    { pg8::StaticOrder S; S.init(M, DM, F.G, F.bid); pg8::Gemm g{(const bf16*)(ws + WS_MG), (const bf16*)(ws + WS_WOUT), M, DM, DM}; EpiF<0> E{(float*)(ws + WS_MO), nullptr, nullptr, nullptr, nullptr};
      pg8::gemm_phase<EpiF<0>, pg8::StaticOrder, true, true>(F.lds, g, S, E); }
#endif

    GRID_BAR();
    norm_rows<0>(F, (const float*)(ws + WS_MO), F.A->in[15], F.A->in[16], (bf16*)(ws + WS_N2));
#ifdef PROBE_NORMA
    LAUNDER(); norm_rows<0>(F, (const float*)(ws + WS_MO), F.A->in[15], F.A->in[16], (bf16*)(ws + WS_N2));
#endif
#ifdef PROBE_BAR
    for (int i = 0; i < PROBE_BAR; ++i) GRID_BAR();
#endif
    GRID_BAR();
#ifndef SKIP_FF1
    { pg8::StaticOrder S; S.init(M, DFF, F.G, F.bid); pg8::Gemm g{(const bf16*)(ws + WS_N2), (const bf16*)(ws + WS_WFF1), M, DFF, DM}; EpiRelu2 E{(bf16*)(ws + WS_HID)};
      pg8::gemm_phase<EpiRelu2, pg8::StaticOrder, true, true>(F.lds, g, S, E); }
#endif

    GRID_BAR();
#ifndef SKIP_FF2
    { pg8::StaticOrder S; S.init(M, DM, F.G, F.bid); pg8::Gemm g{(const bf16*)(ws + WS_HID), (const bf16*)(ws + WS_WFF2), M, DM, DFF}; EpiF<0> E{(float*)(ws + WS_FO), nullptr, nullptr, nullptr, nullptr};
      pg8::gemm_phase<EpiF<0>, pg8::StaticOrder, true, true>(F.lds, g, S, E); }
#endif

    GRID_BAR();
    norm_rows<1>(F, (const float*)(ws + WS_FO), F.A->in[19], nullptr, (bf16*)(ws + WS_H2B));
    {
        const f32x4* ps = (const f32x4*)F.A->in[1]; v2u* pd = (v2u*)(ws + WS_PB);
        for (int i = F.bid * 512 + F.tid; i < M * 256 / 4; i += F.G * 512) { const f32x4 v = ps[i]; v2u o; o.x = pk2(v.x, v.y); o.y = pk2(v.z, v.w); pd[i] = o; }
    }
    GRID_BAR();
#ifndef SKIP_PLE
    {
        pg8::StaticOrder S; S.init(M, DM, F.G, F.bid); float* PL = (float*)(ws + WS_PL);
        { pg8::Gemm g{(const bf16*)(ws + WS_PB), (const bf16*)(ws + WS_WPLE), M, DM, 256}; EpiF<0> E{PL, nullptr, nullptr, nullptr, nullptr}; pg8::gemm_phase<EpiF<0>, pg8::StaticOrder, true, true>(F.lds, g, S, E); }
        { pg8::Gemm g{(const bf16*)(ws + WS_H2B), (const bf16*)(ws + WS_WPG), M, DM, DM}; EpiF<1> E{PL, nullptr, nullptr, nullptr, nullptr}; pg8::gemm_phase<EpiF<1>, pg8::StaticOrder, true, true>(F.lds, g, S, E); }
    }
#endif

    GRID_BAR();
    norm_rows<2>(F, (const float*)(ws + WS_PL), F.A->in[22], nullptr, nullptr);
}

extern "C" void kernel_launch(void* const* d_in, const int* in_sizes, int n_in, void* d_out, int out_size, void* d_ws, size_t ws_size, hipStream_t stream) {
    static int grid = 0;
    if (grid == 0) {
        int dev = 0, cus = 0, per_cu = 0;
        (void)hipGetDevice(&dev); (void)hipDeviceGetAttribute(&cus, hipDeviceAttributeMultiprocessorCount, dev);
        (void)hipFuncSetAttribute((const void*)fwd_megakernel, hipFuncAttributeMaxDynamicSharedMemorySize, LDS_TOTAL);
        if (hipOccupancyMaxActiveBlocksPerMultiprocessor(&per_cu, (const void*)fwd_megakernel, 512, LDS_TOTAL) != hipSuccess || per_cu < 1) per_cu = 1;
        (void)hipGetLastError();
        grid = cus * (per_cu > 1 ? 1 : per_cu);
        if (n_in != 23 || ws_size < 256 * MiB) fprintf(stderr, "kernel_launch: unexpected n_in %d / ws_size %zu\n", n_in, ws_size);
    }
    (void)hipMemsetAsync((char*)d_ws + WS_CTL, 0, CTL_BYTES, stream);
    Args a{};
    for (int i = 0; i < 23; ++i) a.in[i] = (const float*)d_in[i];
    a.out = (float*)d_out; a.ws = (unsigned char*)d_ws;
    void* kargs[] = {&a};
    hipError_t e = hipLaunchCooperativeKernel((const void*)fwd_megakernel, dim3(grid), dim3(512), kargs, LDS_TOTAL, stream);
    if (e != hipSuccess) fprintf(stderr, "cooperative launch failed: %s (grid %d)\n", hipGetErrorString(e), grid);
}
```
